# Optimizing an MI355X kernel written in HIP

```python
import math
import jax, jax.numpy as jnp
from jax import lax
import numpy as np

D_MODEL = 2048
BATCH = 16
SEQ = 2048
DEPTH = 4

HEAD_DIM = 128
BLOCK = 128
SWA_Q_HEADS = 8
SWA_KV_HEADS = 2
WINDOW = 128
SB_HEADS = 4
MLA_HEADS = 4
MLA_Q_RANK = 512
MLA_KV_RANK = 512
MLA_NOPE = 128
MLA_ROPE = 64
MLA_V = 128
ROPE_THETA = 10000.0
MEM_LEN = 256
XA_HEADS = 4
REL_BUCKETS = 32
REL_MAX_DIST = 128
D_FF = ((8 * D_MODEL + 3 * 256 - 1) // (3 * 256)) * 256
EPS = 1e-6

WA = SWA_Q_HEADS * HEAD_DIM
KVA = SWA_KV_HEADS * HEAD_DIM
WB = SB_HEADS * HEAD_DIM
WC = MLA_HEADS * MLA_V
MIX_W = WA + WB + WC
XA_W = XA_HEADS * HEAD_DIM
MLA_QK = MLA_NOPE + MLA_ROPE
IN_SIZES = (WA, KVA, KVA, WB, WB, WB, MLA_Q_RANK, MLA_KV_RANK, MLA_ROPE, 3 * D_MODEL)
IN_W = WA + 2 * KVA + 3 * WB + MLA_Q_RANK + MLA_KV_RANK + MLA_ROPE + 3 * D_MODEL

kernel_name = 'hybrid_gated_swa_stickbreak_mla_block'


def split_offsets(sizes):
    out, acc = [], 0
    for s in sizes[:-1]:
        acc += s
        out.append(acc)
    return out


def rms_norm(x, g):
    xf = x.astype(jnp.float32)
    y = xf * lax.rsqrt(jnp.mean(xf * xf, axis=-1, keepdims=True) + EPS)
    return (y * g.astype(jnp.float32)).astype(x.dtype)


def rope(x, positions):
    half = x.shape[-1] // 2
    inv = ROPE_THETA ** (-jnp.arange(half, dtype=jnp.float32) / half)
    ang = positions.astype(jnp.float32)[:, :, None, None] * inv
    cos, sin = jnp.cos(ang), jnp.sin(ang)
    xf = x.astype(jnp.float32)
    x1, x2 = xf[..., :half], xf[..., half:]
    return jnp.concatenate([x1 * cos - x2 * sin, x1 * sin + x2 * cos], axis=-1).astype(x.dtype)


def t5_bucket(rel):
    n = jnp.maximum(rel, 0)
    exact = REL_BUCKETS // 2
    nf = jnp.maximum(n, exact).astype(jnp.float32)
    large = exact + (jnp.log(nf / exact) / math.log(REL_MAX_DIST / exact)
                     * (REL_BUCKETS - exact)).astype(jnp.int32)
    large = jnp.minimum(large, REL_BUCKETS - 1)
    return jnp.where(n < exact, n, large)


def sliding_window_attention(q, k, v, bias, sinks):
    b, s, hq, d = q.shape
    hkv = k.shape[2]
    g = hq // hkv
    nb = s // BLOCK
    qb = q.reshape(b, nb, BLOCK, hkv, g, d)

    def band(t):
        tb = t.reshape(b, nb, BLOCK, hkv, d)
        prev = jnp.concatenate([jnp.zeros_like(tb[:, :1]), tb[:, :-1]], axis=1)
        return jnp.concatenate([prev, tb], axis=2)

    kb, vb = band(k), band(v)
    scores = jnp.einsum('bnqhgd,bnkhd->bnhgqk', qb, kb).astype(jnp.float32) * (d ** -0.5)
    scores = scores + bias.reshape(hkv, g, BLOCK, 2 * BLOCK).astype(jnp.float32)
    i = jnp.arange(BLOCK)[:, None]
    j = jnp.arange(2 * BLOCK)[None, :]
    rel = BLOCK + i - j
    in_window = (rel >= 0) & (rel < WINDOW)
    real_key = (jnp.arange(nb)[:, None, None] > 0) | (j >= BLOCK)[None]
    mask = in_window[None] & real_key
    scores = jnp.where(mask[None, :, None, None], scores, -jnp.inf)
    sink = sinks.astype(jnp.float32).reshape(1, 1, hkv, g, 1, 1)
    m = jnp.maximum(scores.max(axis=-1, keepdims=True), sink)
    p = jnp.exp(scores - m)
    probs = p / (p.sum(axis=-1, keepdims=True) + jnp.exp(sink - m))
    out = jnp.einsum('bnhgqk,bnkhd->bnqhgd', probs.astype(v.dtype), vb)
    return out.reshape(b, s, hq * d)


def stick_breaking_attention(q, k, v):
    b, s, h, d = q.shape
    nb = s // BLOCK
    qb = jnp.moveaxis(q.reshape(b, nb, BLOCK, h, d), 1, 0)
    key_pos = jnp.arange(s)

    def one_block(args):
        qblk, blk = args
        z = jnp.einsum('bqhd,bkhd->bhqk', qblk, k).astype(jnp.float32) * (d ** -0.5)
        qpos = blk * BLOCK + jnp.arange(BLOCK)
        earlier = key_pos[None, :] < qpos[:, None]
        log_keep = jnp.where(earlier, jax.nn.log_sigmoid(-z), 0.0)
        between = lax.cumsum(log_keep, axis=3, reverse=True) - log_keep
        weight = jnp.where(earlier, jnp.exp(jax.nn.log_sigmoid(z) + between), 0.0)
        return jnp.einsum('bhqk,bkhd->bqhd', weight.astype(v.dtype), v)

    out = lax.map(one_block, (qb, jnp.arange(nb)))
    return jnp.moveaxis(out, 0, 1).reshape(b, s, h * d)


def mla_attention(q_nope, q_rope, k_nope, k_rope, v):
    b, s, h, _ = q_nope.shape
    nb = s // BLOCK
    scale = MLA_QK ** -0.5
    qn = jnp.moveaxis(q_nope.reshape(b, nb, BLOCK, h, MLA_NOPE), 1, 0)
    qr = jnp.moveaxis(q_rope.reshape(b, nb, BLOCK, h, MLA_ROPE), 1, 0)
    key_pos = jnp.arange(s)

    def one_block(args):
        qn_b, qr_b, blk = args
        scores = (jnp.einsum('bqhn,bkhn->bhqk', qn_b, k_nope).astype(jnp.float32)
                  + jnp.einsum('bqhr,bkr->bhqk', qr_b, k_rope).astype(jnp.float32)) * scale
        qpos = blk * BLOCK + jnp.arange(BLOCK)
        causal = key_pos[None, :] <= qpos[:, None]
        p = jax.nn.softmax(jnp.where(causal, scores, -jnp.inf), axis=-1)
        return jnp.einsum('bhqk,bkhv->bqhv', p.astype(v.dtype), v)

    out = lax.map(one_block, (qn, qr, jnp.arange(nb)))
    return jnp.moveaxis(out, 0, 1).reshape(b, s, h * MLA_V)


def memory_cross_attention(xn, memn, wq, wkv, q_g, k_g, wo):
    b, s, _ = xn.shape
    m = memn.shape[1]
    q = rms_norm((xn @ wq).reshape(b, s, XA_HEADS, HEAD_DIM), q_g)
    k, v = jnp.split((memn @ wkv).reshape(b, m, XA_HEADS, 2 * HEAD_DIM), 2, axis=-1)
    k = rms_norm(k, k_g)
    scores = jnp.einsum('bqhd,bkhd->bhqk', q, k).astype(jnp.float32) * (HEAD_DIM ** -0.5)
    p = jax.nn.softmax(scores, axis=-1)
    o = jnp.einsum('bhqk,bkhd->bqhd', p.astype(v.dtype), v).reshape(b, s, XA_W)
    return o @ wo


def swiglu(hn, w_gu, w_down):
    gate, up = jnp.split(hn @ w_gu, 2, axis=-1)
    return (jax.nn.silu(gate) * up) @ w_down


def setup_inputs(seed: int = 0) -> dict:
    key = jax.random.key(seed)
    ks = jax.random.split(key, 32)

    def nrm(k, shape, fan_in):
        return jax.random.normal(k, shape, jnp.float32) * (fan_in ** -0.5)

    def gain(k, shape):
        return 1.0 + 0.05 * jax.random.normal(k, shape, jnp.float32)

    start = jax.random.randint(ks[2], (BATCH, 1), 0, 4096, dtype=jnp.int32)
    positions = (start + jnp.arange(SEQ, dtype=jnp.int32)[None, :]).astype(jnp.int32)
    return {
        'x': jax.random.normal(ks[0], (BATCH, SEQ, D_MODEL), jnp.float32),
        'mem': jax.random.normal(ks[1], (BATCH, MEM_LEN, D_MODEL), jnp.float32),
        'positions': positions,
        'rel_bias': 0.5 * jax.random.normal(ks[3], (REL_BUCKETS, SWA_Q_HEADS), jnp.float32),
        'norm_mix': gain(ks[4], (DEPTH, D_MODEL)),
        'w_in': nrm(ks[5], (DEPTH, D_MODEL, IN_W), D_MODEL),
        'swa_q_norm': gain(ks[6], (DEPTH, HEAD_DIM)),
        'swa_k_norm': gain(ks[7], (DEPTH, HEAD_DIM)),
        'swa_sinks': jax.random.normal(ks[8], (DEPTH, SWA_Q_HEADS), jnp.float32),
        'mla_cq_norm': gain(ks[9], (DEPTH, MLA_Q_RANK)),
        'mla_ckv_norm': gain(ks[10], (DEPTH, MLA_KV_RANK)),
        'mla_w_uq': nrm(ks[11], (DEPTH, MLA_Q_RANK, MLA_HEADS * MLA_QK), MLA_Q_RANK),
        'mla_w_ukv': nrm(ks[12], (DEPTH, MLA_KV_RANK, MLA_HEADS * (MLA_NOPE + MLA_V)), MLA_KV_RANK),
        'mla_q_norm': gain(ks[13], (DEPTH, MLA_QK)),
        'mla_k_norm': gain(ks[14], (DEPTH, MLA_QK)),
        'w_branch': nrm(ks[15], (DEPTH, MIX_W, D_MODEL), MIX_W),
        'w_out': nrm(ks[16], (DEPTH, D_MODEL, D_MODEL), D_MODEL),
        'norm_xa': gain(ks[17], (DEPTH, D_MODEL)),
        'norm_mem': gain(ks[18], (DEPTH, D_MODEL)),
        'xa_wq': nrm(ks[19], (DEPTH, D_MODEL, XA_W), D_MODEL),
        'xa_wkv': nrm(ks[20], (DEPTH, D_MODEL, 2 * XA_W), D_MODEL),
        'xa_q_norm': gain(ks[21], (DEPTH, HEAD_DIM)),
        'xa_k_norm': gain(ks[22], (DEPTH, HEAD_DIM)),
        'xa_wo': nrm(ks[23], (DEPTH, XA_W, D_MODEL), XA_W),
        'norm_ffn': gain(ks[24], (DEPTH, D_MODEL)),
        'ffn_w_gu': nrm(ks[25], (DEPTH, D_MODEL, 2 * D_FF), D_MODEL),
        'ffn_w_down': nrm(ks[26], (DEPTH, D_FF, D_MODEL), D_FF),
    }


def reference(x, mem, positions, rel_bias, norm_mix, w_in, swa_q_norm, swa_k_norm, swa_sinks,
              mla_cq_norm, mla_ckv_norm, mla_w_uq, mla_w_ukv, mla_q_norm, mla_k_norm,
              w_branch, w_out, norm_xa, norm_mem, xa_wq, xa_wkv, xa_q_norm, xa_k_norm, xa_wo,
              norm_ffn, ffn_w_gu, ffn_w_down):
    b, s, _ = x.shape
    offsets = split_offsets(IN_SIZES)

    i = jnp.arange(BLOCK)[:, None]
    j = jnp.arange(2 * BLOCK)[None, :]
    swa_bias = jnp.transpose(rel_bias[t5_bucket(BLOCK + i - j)], (2, 0, 1))

    for l in range(DEPTH):
        h = rms_norm(x, norm_mix[l])
        qa, ka, va, qb, kb, vb, cq, ckv, kr, gates = jnp.split(h @ w_in[l], offsets, axis=-1)

        qa = rms_norm(qa.reshape(b, s, SWA_Q_HEADS, HEAD_DIM), swa_q_norm[l])
        ka = rms_norm(ka.reshape(b, s, SWA_KV_HEADS, HEAD_DIM), swa_k_norm[l])
        va = va.reshape(b, s, SWA_KV_HEADS, HEAD_DIM)
        o_a = sliding_window_attention(qa, ka, va, swa_bias, swa_sinks[l])

        o_b = stick_breaking_attention(qb.reshape(b, s, SB_HEADS, HEAD_DIM),
                                       kb.reshape(b, s, SB_HEADS, HEAD_DIM),
                                       vb.reshape(b, s, SB_HEADS, HEAD_DIM))

        q_c = (rms_norm(cq, mla_cq_norm[l]) @ mla_w_uq[l]).reshape(b, s, MLA_HEADS, MLA_QK)
        kv_c = (rms_norm(ckv, mla_ckv_norm[l]) @ mla_w_ukv[l]).reshape(b, s, MLA_HEADS, MLA_NOPE + MLA_V)
        qg, kg = mla_q_norm[l], mla_k_norm[l]
        q_nope = rms_norm(q_c[..., :MLA_NOPE], qg[:MLA_NOPE])
        q_rope = rope(rms_norm(q_c[..., MLA_NOPE:], qg[MLA_NOPE:]), positions)
        k_nope = rms_norm(kv_c[..., :MLA_NOPE], kg[:MLA_NOPE])
        v_c = kv_c[..., MLA_NOPE:]
        k_rope = rope(rms_norm(kr, kg[MLA_NOPE:])[:, :, None, :], positions)[:, :, 0, :]
        o_c = mla_attention(q_nope, q_rope, k_nope, k_rope, v_c)

        g_a, g_b, g_c = jnp.split(jax.nn.sigmoid(gates), 3, axis=-1)
        wbr = w_branch[l]
        merged = (g_a * (o_a @ wbr[:WA])
                  + g_b * (o_b @ wbr[WA:WA + WB])
                  + g_c * (o_c @ wbr[WA + WB:]))
        x = x + merged @ w_out[l]

        x = x + memory_cross_attention(rms_norm(x, norm_xa[l]), rms_norm(mem, norm_mem[l]),
                                       xa_wq[l], xa_wkv[l], xa_q_norm[l], xa_k_norm[l], xa_wo[l])

        x = x + swiglu(rms_norm(x, norm_ffn[l]), ffn_w_gu[l], ffn_w_down[l])
    return x
```

```cpp
#include <hip/hip_runtime.h>
#include <cstdio>
#include <cstdint>

#ifndef PHASE_MASK
#define PHASE_MASK 0xFFFFFFFFull
#endif
#define PHON(k) (((PHASE_MASK) >> (k)) & 1ull)
#ifndef MK_ONE_LAUNCH
#define MK_ONE_LAUNCH 0
#endif

#define GAS __attribute__((address_space(1)))
#define LAS __attribute__((address_space(3)))
typedef unsigned short bf16_t;
typedef short bf16x8 __attribute__((ext_vector_type(8)));
typedef short s16x4 __attribute__((ext_vector_type(4)));
typedef float f32x2 __attribute__((ext_vector_type(2)));
typedef float f32x4 __attribute__((ext_vector_type(4)));
typedef float f32x16 __attribute__((ext_vector_type(16)));
typedef unsigned u32x2 __attribute__((ext_vector_type(2)));
typedef unsigned u32x4 __attribute__((ext_vector_type(4)));
typedef GAS unsigned gu32;

constexpr int BATCH = 16, SEQ = 2048, DM = 2048, M = BATCH * SEQ, DEPTH = 4;
constexpr int MEMLEN = 256, MMEM = BATCH * MEMLEN;
constexpr int IN_W = 10304, LDI = 10496;
constexpr int DFF = 5632;
constexpr float EPS = 1e-6f;
constexpr float LOG2E = 1.4426950408889634f;
constexpr int C_QA = 0, C_KA = 1024, C_VA = 1280, C_QB = 1536, C_KB = 2048, C_VB = 2560, C_CQ = 3072, C_CKV = 3584, C_G = 4096, C_KR = 10240;
constexpr int NP = 18;
constexpr int NPRE = 3;
constexpr int NPHASE = NPRE + DEPTH * NP;

constexpr size_t MiB = 1u << 20;
constexpr size_t WS_CTL = 0, CTL_ZERO_BYTES = 1 * MiB;
constexpr size_t WS_TAB = 1 * MiB;
constexpr size_t WS_WL = 2 * MiB;
constexpr size_t WL_IN = 0, WL_GU = 41 * MiB, WL_DN = 85 * MiB, WL_BR = 107 * MiB, WL_OUT = 115 * MiB, WL_XQ = 123 * MiB, WL_XO = 125 * MiB, WL_UKV = 127 * MiB, WL_UQ = 128 * MiB;
constexpr size_t WS_WXKV = 132 * MiB;
constexpr size_t WS_IN = 148 * MiB;
constexpr size_t WS_XN = 804 * MiB;
constexpr size_t WS_MRG = 932 * MiB;
constexpr size_t WS_QC = 1060 * MiB;
constexpr size_t WS_KVC = 1108 * MiB;
constexpr size_t WS_KR = 1172 * MiB;
constexpr size_t WS_MEMN = 1176 * MiB;
constexpr size_t WS_XKV = 1192 * MiB;
constexpr size_t WS_XQ = 1224 * MiB;
constexpr size_t WS_XO = 1256 * MiB;
constexpr size_t WS_END = 1288 * MiB;
static_assert(WS_IN + (size_t)M * LDI * 2 <= WS_XN && WL_UQ + 768 * 512 * 2 <= 130 * MiB, "ws map");

constexpr int RING_BYTES = 131072;
constexpr int LDSCTL_OFF = RING_BYTES, MISC_OFF = LDSCTL_OFF + 320, PT_OFF = LDSCTL_OFF + 1024;
constexpr int LDS_BYTES = 147456;
constexpr int NWAVES = 8;

#define RLX_AGENT __ATOMIC_RELAXED, __HIP_MEMORY_SCOPE_AGENT
#define LDS_WAIT() asm volatile("s_waitcnt lgkmcnt(0)" ::: "memory")
#define VM_WAIT() asm volatile("s_waitcnt vmcnt(0)" ::: "memory")
__device__ __forceinline__ unsigned cvt_pk_bf16(float lo, float hi) { unsigned r; asm volatile("v_cvt_pk_bf16_f32 %0, %1, %2" : "=v"(r) : "v"(lo), "v"(hi)); return r; }
__device__ __forceinline__ float bf2f(short h) { return __builtin_bit_cast(float, ((unsigned)(unsigned short)h) << 16); }
__device__ __forceinline__ float wave_sum(float v) {
#pragma unroll
    for (int o = 1; o < 64; o <<= 1) v += __shfl_xor(v, o);
    return v;
}
__device__ __forceinline__ float wave_max(float v) {
#pragma unroll
    for (int o = 1; o < 64; o <<= 1) v = fmaxf(v, __shfl_xor(v, o));
    return v;
}
__device__ __forceinline__ float fast_exp2(float x) { return __builtin_amdgcn_exp2f(x); }
__device__ __forceinline__ float fast_rcp(float x) { return __builtin_amdgcn_rcpf(x); }
__device__ __forceinline__ float sigmoidf_(float z) { return fast_rcp(1.f + fast_exp2(-z * LOG2E)); }
__device__ __forceinline__ u32x4 pack8(const float* v) { u32x4 w; w.x = cvt_pk_bf16(v[0], v[1]); w.y = cvt_pk_bf16(v[2], v[3]); w.z = cvt_pk_bf16(v[4], v[5]); w.w = cvt_pk_bf16(v[6], v[7]); return w; }

namespace pg8 {
constexpr int BM = 256, BK = 64, HALF = 128, HTB = HALF * BK * 2, NXCD = 8, WGM = 8;
__host__ __device__ __forceinline__ int lds_byte(int r, int c) { const int st = (r >> 4) * 2 + (c >> 5), rr = r & 15, cc = c & 31, ob = rr * 64 + cc * 2; return st * 1024 + (ob ^ (((ob >> 9) & 1) << 5)); }
__host__ __device__ __forceinline__ void stage_rc(int b, int& R, int& C) { const int st = b / 1024, sb = b % 1024, swz = sb ^ (((sb >> 9) & 1) << 5); R = (st >> 1) * 16 + swz / 64; C = (st & 1) * 32 + (swz % 64) / 2; }
__host__ __device__ __forceinline__ int perm32(int rho) { const int n = rho >> 4, i = rho & 15; return 8 * (i >> 2) + 4 * n + (i & 3); }

struct GUnit { const char* A; const char* B; int nt; int pm, pn, seg; };

struct TileOrder {
    int nM, nN, nwg, G, c;
    __device__ void init(int nM_, int nN_, int G_, int c_) { nM = nM_; nN = nN_; nwg = nM * nN; G = G_; c = c_; }
    __device__ bool tile(int i, int& pm, int& pn) const {
        const long L = (long)i * G + c; if (L >= nwg) return false;
        int wgid = (int)L; { const int q = nwg / NXCD, r = nwg % NXCD, xcd = wgid % NXCD, off = wgid / NXCD; wgid = (xcd < r ? xcd * (q + 1) : r * (q + 1) + (xcd - r) * q) + off; }
        const int nig = WGM * nN, gid = wgid / nig, fm = gid * WGM, gsz = (nM - fm) < WGM ? (nM - fm) : WGM;
        pm = fm + ((wgid % nig) % gsz); pn = (wgid % nig) / gsz; return true;
    }
};
struct SchedSimple {
    TileOrder T; const char* A; const char* B; size_t tA, tB; int nt;
    __device__ void init(const bf16_t* A_, int lda, const bf16_t* B_, int ldb, int Mr, int N, int K, int G, int c) { T.init(Mr / BM, N / BM, G, c); A = (const char*)A_; B = (const char*)B_; tA = (size_t)BM * lda * 2; tB = (size_t)BM * ldb * 2; nt = K / BK; }
    __device__ bool next(int i, GUnit& u) const { int pm, pn; if (!T.tile(i, pm, pn)) return false; u.A = A + pm * tA; u.B = B + pn * tB; u.nt = nt; u.pm = pm; u.pn = pn; u.seg = 0; return true; }
};
struct SchedBranch {
    TileOrder T; const char* A; const char* B; size_t tA, tB;
    __device__ void init(const bf16_t* A_, const bf16_t* B_, int G, int c) { T.init(M / BM, DM / BM, G, c); A = (const char*)A_; B = (const char*)B_; tA = (size_t)BM * DM * 2; tB = (size_t)BM * DM * 2; }
    __device__ bool next(int i, GUnit& u) const { int pm, pn; const int ti = i / 3, seg = i - 3 * ti; if (!T.tile(ti, pm, pn)) return false;
        const int koff = seg == 0 ? 0 : (seg == 1 ? 1024 : 1536); u.A = A + pm * tA + koff * 2; u.B = B + pn * tB + koff * 2; u.nt = seg == 0 ? 16 : 8; u.pm = pm; u.pn = pn; u.seg = seg; return true; }
};

struct EpiStore {
    bf16_t* O; int ldc; int sig_lo, sig_hi;
    __device__ __forceinline__ bool operator()(f32x4 (&acc)[2][2][4][2], const GUnit& u, int wr, int wc, int fr, int fq) const {
        const int row0 = u.pm * BM + wr * 64 + fr, col0 = u.pn * BM + wc * 32 + 8 * fq; const bool sig = u.pn >= sig_lo && u.pn < sig_hi;
#pragma unroll
        for (int ai = 0; ai < 2; ++ai)
#pragma unroll
            for (int m = 0; m < 4; ++m) { bf16_t* rowp = O + (size_t)(row0 + ai * HALF + m * 16) * ldc + col0;
#pragma unroll
                for (int bj = 0; bj < 2; ++bj) { float v[8];
#pragma unroll
                    for (int j = 0; j < 4; ++j) { v[j] = acc[ai][bj][m][0][j]; v[4 + j] = acc[ai][bj][m][1][j]; }
                    if (sig) {
#pragma unroll
                        for (int j = 0; j < 8; ++j) v[j] = fmaxf(sigmoidf_(v[j]), 1e-18f); }
                    *(u32x4*)(rowp + bj * HALF) = pack8(v); } }
        return true;
    }
};
struct EpiRes {
    const float* base; float* out;
    __device__ __forceinline__ bool operator()(f32x4 (&acc)[2][2][4][2], const GUnit& u, int wr, int wc, int fr, int fq) const {
        const int row0 = u.pm * BM + wr * 64 + fr, col0 = u.pn * BM + wc * 32 + 8 * fq;
#pragma unroll
        for (int ai = 0; ai < 2; ++ai)
#pragma unroll
            for (int m = 0; m < 4; ++m) { const size_t off = (size_t)(row0 + ai * HALF + m * 16) * DM + col0;
#pragma unroll
                for (int bj = 0; bj < 2; ++bj)
#pragma unroll
                    for (int n = 0; n < 2; ++n) { const f32x4 b = *(const f32x4*)(base + off + bj * HALF + 4 * n); *(f32x4*)(out + off + bj * HALF + 4 * n) = b + acc[ai][bj][m][n]; } }
        return true;
    }
};
struct EpiSwiglu {
    bf16_t* H;
    __device__ __forceinline__ bool operator()(f32x4 (&acc)[2][2][4][2], const GUnit& u, int wr, int wc, int fr, int fq) const {
        const int row0 = u.pm * BM + wr * 64 + fr, col0 = u.pn * HALF + wc * 32 + 8 * fq;
#pragma unroll
        for (int ai = 0; ai < 2; ++ai)
#pragma unroll
            for (int m = 0; m < 4; ++m) { float v[8];
#pragma unroll
                for (int n = 0; n < 2; ++n)
#pragma unroll
                    for (int j = 0; j < 4; ++j) { const float g = acc[ai][0][m][n][j], up = acc[ai][1][m][n][j]; v[4 * n + j] = g * sigmoidf_(g) * up; }
                *(u32x4*)(H + (size_t)(row0 + ai * HALF + m * 16) * DFF + col0) = pack8(v); }
        return true;
    }
};
struct EpiBranch {
    const bf16_t* G; bf16_t* O;
    __device__ __forceinline__ bool operator()(f32x4 (&acc)[2][2][4][2], const GUnit& u, int wr, int wc, int fr, int fq) const {
        const int row0 = u.pm * BM + wr * 64 + fr, col0 = u.pn * BM + wc * 32 + 8 * fq; const int seg = u.seg;
        const int cn = (seg == 2 ? 2 : seg) * DM, cd = (seg + 1) * DM;
#pragma unroll
        for (int ai = 0; ai < 2; ++ai)
#pragma unroll
            for (int m = 0; m < 4; ++m) { const size_t goff = (size_t)(row0 + ai * HALF + m * 16) * LDI + col0;
#pragma unroll
                for (int bj = 0; bj < 2; ++bj) { const bf16x8 gn = *(const bf16x8*)(G + goff + cn + bj * HALF); float f[8];
                    if (seg < 2) { const bf16x8 gd = *(const bf16x8*)(G + goff + cd + bj * HALF);
#pragma unroll
                        for (int j = 0; j < 8; ++j) f[j] = bf2f(gn[j]) * fast_rcp(bf2f(gd[j])); }
                    else {
#pragma unroll
                        for (int j = 0; j < 8; ++j) f[j] = bf2f(gn[j]); }
#pragma unroll
                    for (int j = 0; j < 4; ++j) { acc[ai][bj][m][0][j] *= f[j]; acc[ai][bj][m][1][j] *= f[4 + j]; }
                    if (seg == 2) { float v[8];
#pragma unroll
                        for (int j = 0; j < 4; ++j) { v[j] = acc[ai][bj][m][0][j]; v[4 + j] = acc[ai][bj][m][1][j]; }
                        *(u32x4*)(O + (size_t)(row0 + ai * HALF + m * 16) * DM + col0 + bj * HALF) = pack8(v); } } }
        return seg == 2;
    }
};

template <class Epi, class Sched, bool ALIGN_EPI, bool SP2>
__device__ __forceinline__ void gemm_phase(LAS unsigned char* lds, const int lda, const int ldb, const Sched& S, const Epi& E) {
    int tid = threadIdx.x; asm volatile("" : "+v"(tid));
    const int wid = __builtin_amdgcn_readfirstlane(tid >> 6), lane = tid & 63, wr = wid >> 2, wc = wid & 3, fr = lane & 15, fq = lane >> 4;
    unsigned voffA[2], voffB[2];
#pragma unroll
    for (int i = 0; i < 2; ++i) { int R, C; stage_rc(tid * 16 + i * 8192, R, C); const int Rb = (R & ~31) + perm32(R & 31);
        voffA[i] = (unsigned)(R * lda + C) * 2u; voffB[i] = (unsigned)(Rb * ldb + C) * 2u; }
    const size_t kstep = (size_t)(BK * 2);
    const size_t hstepA = (size_t)HALF * lda * 2, hstepB = (size_t)HALF * ldb * 2;
    const unsigned ldsw = (unsigned)wid * 1024u;
    const int aoff = lds_byte(wr * 64 + fr, fq * 8), boff = lds_byte(wc * 32 + fr, fq * 8);
#define PG8_SA(b, h) (((b) * 2 + (h)) * HTB)
#define PG8_SB(b, h) ((4 + (b) * 2 + (h)) * HTB)
#define PG8_STAGE(bufoff, gbase, voff) do { _Pragma("unroll") for (int _i = 0; _i < 2; ++_i) \
        __builtin_amdgcn_global_load_lds((const unsigned*)((const char*)(gbase) + (voff)[_i]), (LAS unsigned*)(lds + (bufoff) + ldsw + _i * 8192), 16, 0, 0); } while (0)
#define PG8_LDA(dst, b, h) do { _Pragma("unroll") for (int m = 0; m < 4; ++m) _Pragma("unroll") for (int k = 0; k < 2; ++k) dst[m][k] = *(const LAS bf16x8*)(lds + PG8_SA(b, h) + aoff + m * 2048 + k * 1024); } while (0)
#define PG8_LDB(dst, b, h) do { _Pragma("unroll") for (int n = 0; n < 2; ++n) _Pragma("unroll") for (int k = 0; k < 2; ++k) dst[n][k] = *(const LAS bf16x8*)(lds + PG8_SB(b, h) + boff + n * 2048 + k * 1024); } while (0)
#define PG8_MMA(ai, bj, At, Bt) do { __builtin_amdgcn_s_setprio(1); _Pragma("unroll") for (int m = 0; m < 4; ++m) _Pragma("unroll") for (int n = 0; n < 2; ++n) _Pragma("unroll") for (int k = 0; k < 2; ++k) \
        acc[ai][bj][m][n] = __builtin_amdgcn_mfma_f32_16x16x32_bf16(Bt[n][k], At[m][k], acc[ai][bj][m][n], 0, 0, 0); __builtin_amdgcn_s_setprio(0); } while (0)
#define PG8_WAIT_V(n) asm volatile("s_waitcnt vmcnt(" #n ")" ::: "memory")
#define PG8_WAIT_L(n) asm volatile("s_waitcnt lgkmcnt(" #n ")" ::: "memory")
#define PG8_BAR __builtin_amdgcn_s_barrier()
#define PG8_SCHED __builtin_amdgcn_sched_barrier(0)
    GUnit cur, nxt; int ui = 0;
    if (!S.next(0, cur)) return;
    f32x4 acc[2][2][4][2];
#pragma unroll
    for (int a = 0; a < 2; ++a)
#pragma unroll
        for (int b = 0; b < 2; ++b)
#pragma unroll
            for (int m = 0; m < 4; ++m)
#pragma unroll
                for (int n = 0; n < 2; ++n) acc[a][b][m][n] = (f32x4){0.f, 0.f, 0.f, 0.f};
    bf16x8 At[4][2], B0[2][2], B1[2][2];
    const char* cA = cur.A; const char* cB = cur.B;
    if constexpr (SP2) {
        PG8_STAGE(PG8_SB(0, 0), cB, voffB); PG8_STAGE(PG8_SB(0, 1), cB + hstepB, voffB); PG8_STAGE(PG8_SA(0, 0), cA, voffA); PG8_STAGE(PG8_SA(0, 1), cA + hstepA, voffA);
        if (wr == 1) PG8_BAR;
        PG8_WAIT_V(2); PG8_BAR;
        PG8_STAGE(PG8_SB(1, 0), cB + kstep, voffB); PG8_STAGE(PG8_SA(1, 0), cA + kstep, voffA); PG8_STAGE(PG8_SB(1, 1), cB + hstepB + kstep, voffB);
        PG8_WAIT_V(6); PG8_BAR;
    } else {
        PG8_STAGE(PG8_SB(0, 0), cB, voffB); PG8_STAGE(PG8_SA(0, 0), cA, voffA); PG8_STAGE(PG8_SB(0, 1), cB + hstepB, voffB); PG8_STAGE(PG8_SA(0, 1), cA + hstepA, voffA);
        if (wr == 1) PG8_BAR;
        PG8_WAIT_V(4); PG8_BAR;
        PG8_STAGE(PG8_SB(1, 0), cB + kstep, voffB); PG8_STAGE(PG8_SA(1, 0), cA + kstep, voffA); PG8_STAGE(PG8_SB(1, 1), cB + hstepB + kstep, voffB);
        PG8_WAIT_V(6); PG8_BAR;
    }
    for (;;) {
        const bool has_next = S.next(ui + 1, nxt);
        const char* nA = has_next ? nxt.A : cA; const char* nB = has_next ? nxt.B : cB;
        const int nt = cur.nt;
        for (int t = 0; t < nt; t += 2) {
            const bool last = (t == nt - 2);
            const char* a1 = cA + (size_t)(t + 1) * kstep;
            const char* a2 = last ? nA : cA + (size_t)(t + 2) * kstep; const char* b2 = last ? nB : cB + (size_t)(t + 2) * kstep;
            const char* a3 = a2 + kstep; const char* b3 = b2 + kstep;
            if constexpr (SP2) {
            PG8_LDB(B0, 0, 0); PG8_LDB(B1, 0, 1); PG8_SCHED; PG8_LDA(At, 0, 0); PG8_STAGE(PG8_SA(1, 1), a1 + hstepA, voffA);
            PG8_WAIT_V(8); PG8_WAIT_L(0); PG8_BAR; PG8_MMA(0, 0, At, B0); PG8_MMA(0, 1, At, B1); PG8_BAR; PG8_SCHED;
            PG8_LDA(At, 0, 1); PG8_STAGE(PG8_SB(0, 0), b2, voffB); PG8_STAGE(PG8_SB(0, 1), b2 + hstepB, voffB); PG8_STAGE(PG8_SA(0, 0), a2, voffA);
            PG8_WAIT_V(8); PG8_WAIT_L(0); PG8_BAR; PG8_MMA(1, 0, At, B0); PG8_MMA(1, 1, At, B1); PG8_BAR; PG8_SCHED;
            PG8_LDB(B0, 1, 0); PG8_LDB(B1, 1, 1); PG8_SCHED; PG8_LDA(At, 1, 0); PG8_STAGE(PG8_SA(0, 1), a2 + hstepA, voffA);
            PG8_WAIT_V(8); PG8_WAIT_L(0); PG8_BAR; PG8_MMA(0, 0, At, B0); PG8_MMA(0, 1, At, B1); PG8_BAR; PG8_SCHED;
            PG8_LDA(At, 1, 1); PG8_STAGE(PG8_SB(1, 0), b3, voffB); PG8_STAGE(PG8_SB(1, 1), b3 + hstepB, voffB); PG8_STAGE(PG8_SA(1, 0), a3, voffA);
            PG8_WAIT_V(8); PG8_WAIT_L(0); PG8_BAR; PG8_MMA(1, 0, At, B0); PG8_MMA(1, 1, At, B1); PG8_BAR; PG8_SCHED;
            } else {
            PG8_LDB(B0, 0, 0); PG8_SCHED; PG8_LDA(At, 0, 0); PG8_STAGE(PG8_SA(1, 1), a1 + hstepA, voffA);
            PG8_WAIT_L(8); PG8_BAR; PG8_WAIT_L(0); PG8_MMA(0, 0, At, B0); PG8_BAR; PG8_SCHED;
            PG8_LDB(B1, 0, 1); PG8_STAGE(PG8_SB(0, 0), b2, voffB);
            PG8_BAR; PG8_WAIT_L(0); PG8_MMA(0, 1, At, B1); PG8_BAR;
            PG8_LDA(At, 0, 1); PG8_STAGE(PG8_SA(0, 0), a2, voffA);
            PG8_BAR; PG8_WAIT_L(0); PG8_MMA(1, 0, At, B0); PG8_BAR; PG8_SCHED;
            PG8_STAGE(PG8_SB(0, 1), b2 + hstepB, voffB);
            PG8_WAIT_V(6); PG8_BAR; PG8_MMA(1, 1, At, B1); PG8_BAR;
            PG8_LDB(B0, 1, 0); PG8_SCHED; PG8_LDA(At, 1, 0); PG8_STAGE(PG8_SA(0, 1), a2 + hstepA, voffA);
            PG8_WAIT_L(8); PG8_BAR; PG8_WAIT_L(0); PG8_MMA(0, 0, At, B0); PG8_BAR; PG8_SCHED;
            PG8_LDB(B1, 1, 1); PG8_STAGE(PG8_SB(1, 0), b3, voffB);
            PG8_BAR; PG8_WAIT_L(0); PG8_MMA(0, 1, At, B1); PG8_BAR;
            PG8_LDA(At, 1, 1); PG8_STAGE(PG8_SA(1, 0), a3, voffA);
            PG8_BAR; PG8_WAIT_L(0); PG8_MMA(1, 0, At, B0); PG8_BAR; PG8_SCHED;
            PG8_STAGE(PG8_SB(1, 1), b3 + hstepB, voffB);
            PG8_WAIT_V(6); PG8_BAR; PG8_MMA(1, 1, At, B1); PG8_BAR;
            }
        }
        if constexpr (ALIGN_EPI) { if (wr == 0) PG8_BAR; }
        const bool zero = E(acc, cur, wr, wc, fr, fq);
        if (!has_next) break;
        if (zero) {
#pragma unroll
        for (int a = 0; a < 2; ++a)
#pragma unroll
            for (int b = 0; b < 2; ++b)
#pragma unroll
                for (int m = 0; m < 4; ++m)
#pragma unroll
                    for (int n = 0; n < 2; ++n) acc[a][b][m][n] = (f32x4){0.f, 0.f, 0.f, 0.f};
        }
        cur = nxt; cA = nA; cB = nB; ++ui;
        if constexpr (ALIGN_EPI) { if (wr == 1) PG8_BAR; }
    }
    PG8_WAIT_V(0);
    if constexpr (!ALIGN_EPI) { if (wr == 0) PG8_BAR; }
    PG8_BAR;
#undef PG8_SA
#undef PG8_SB
#undef PG8_STAGE
#undef PG8_LDA
#undef PG8_LDB
#undef PG8_MMA
#undef PG8_WAIT_V
#undef PG8_WAIT_L
#undef PG8_BAR
#undef PG8_SCHED
}
}

#define XB_TMO      128
#define XB_XCNT(j)  (256  + 64 * (j))
#define XB_XSUB(j)  (1280 + 64 * (j))
#define XB_XGEN(j)  (2304 + 64 * (j))
#define XB_TOP      3328
#define XB_TOPGEN   3392
#define XCD_BAR_WORDS 3456
#define XB_SPIN_CAP (1u << 18)
__device__ __forceinline__ unsigned xb_ld(unsigned* p)              { return __hip_atomic_load(p, __ATOMIC_RELAXED, __HIP_MEMORY_SCOPE_AGENT); }
__device__ __forceinline__ unsigned xb_add(unsigned* p, unsigned v) { return __hip_atomic_fetch_add(p, v, __ATOMIC_RELAXED, __HIP_MEMORY_SCOPE_AGENT); }
__device__ __forceinline__ unsigned xb_xcc_id() { return (unsigned)__builtin_amdgcn_s_getreg((3 << 11) | 20) & 0xFu; }
#define XB_SPIN(cond, bar) do { unsigned _sp = 0; while (cond) { __builtin_amdgcn_s_sleep(1); \
    if ((++_sp & 255u) == 0u) { if (xb_ld(&(bar)[XB_TMO])) break; if (_sp > XB_SPIN_CAP) { atomicAdd(&(bar)[XB_TMO], 1u); break; } } } } while (0)
struct XcdBarrier { unsigned* bar; unsigned x; volatile LAS unsigned* st; };
__device__ __forceinline__ XcdBarrier xcd_barrier_post(unsigned* bar, volatile LAS unsigned* st) {
    XcdBarrier b; b.bar = bar; b.x = xb_xcc_id(); b.st = st;
    if (threadIdx.x == 0) (void)xb_add(&bar[XB_XCNT(b.x)], 1u);
    return b;
}
__device__ __forceinline__ void xcd_barrier_complete(unsigned* bar, unsigned x, unsigned& nloc, unsigned& nx) {
    const unsigned G = gridDim.x * gridDim.y * gridDim.z;
    unsigned sum, cnt, mine, sp = 0u;
    for (;;) {
        sum = 0u; cnt = 0u; mine = 0u;
#pragma unroll
        for (unsigned j = 0; j < 16; ++j) { const unsigned c = xb_ld(&bar[XB_XCNT(j)]); sum += c; cnt += (c > 0u) ? 1u : 0u; mine = (j == x) ? c : mine; }
        if (sum == G) break;
        __builtin_amdgcn_s_sleep(1);
        if ((++sp & 255u) == 0u) { if (xb_ld(&bar[XB_TMO])) break; if (sp > XB_SPIN_CAP) { atomicAdd(&bar[XB_TMO], 1u); break; } }
    }
    nloc = mine > 0u ? mine : 1u; nx = cnt > 0u ? cnt : 1u;
}
__device__ __forceinline__ void xcd_barrier(const XcdBarrier& b) {
    asm volatile("s_waitcnt vmcnt(0)" ::: "memory");
    __syncthreads();
    if (threadIdx.x == 0) {
        unsigned* bar = b.bar;
        __builtin_amdgcn_s_waitcnt(0);
        unsigned nloc = b.st[0], nx = b.st[1];
        if (nloc == 0u) { xcd_barrier_complete(bar, b.x, nloc, nx); b.st[0] = nloc; b.st[1] = nx; }
        const unsigned old = xb_add(&bar[XB_XSUB(b.x)], 1u);
        const unsigned gen = old / nloc;
        if (old + 1u == (gen + 1u) * nloc) {
            __builtin_amdgcn_fence(__ATOMIC_RELEASE, "agent");
            asm volatile("s_waitcnt vmcnt(0)" ::: "memory");
            const unsigned og = xb_add(&bar[XB_TOP], 1u);
            const unsigned tg = og / nx;
            if (og + 1u == (tg + 1u) * nx) xb_add(&bar[XB_TOPGEN], 1u);
            else XB_SPIN(xb_ld(&bar[XB_TOPGEN]) == tg, bar);
            __builtin_amdgcn_fence(__ATOMIC_ACQUIRE, "agent");
            xb_add(&bar[XB_XGEN(b.x)], 1u);
            asm volatile("s_waitcnt vmcnt(0)" ::: "memory");
        } else {
            XB_SPIN(xb_ld(&bar[XB_XGEN(b.x)]) == gen, bar);
            __builtin_amdgcn_fence(__ATOMIC_ACQUIRE, "agent");
            asm volatile("s_waitcnt vmcnt(0)" ::: "memory");
        }
    }
    __syncthreads();
}
constexpr int CW_BAR = 4096;

struct Args { const float* in[27]; const int* pos; float* out; unsigned char* ws; int ph_lo, ph_hi; };

struct Frame {
    LAS unsigned char* lds; int tid, lane, wave, G, gw, NGW;
};

__device__ __forceinline__ int map_src_col(int maptype, int n0) {
    if (maptype == 0) return n0;
    if (maptype == 1) { if (n0 < 4096) return n0; if (n0 < 10240) return n0 + 64; if (n0 < 10304) return n0 - 6144; return -1; }
    const int pn = n0 >> 8, r = n0 & 255; return r < 128 ? 128 * pn + r : DFF + 128 * pn + (r - 128);
}
__device__ __forceinline__ void transpose_item(const float* W, int K, int Nsrc, bf16_t* WT, int nblk, const float* gain, int maptype, LAS float* scr, int item, int lane) {
    const int kb = item / nblk, nb = item % nblk, k0 = 64 * kb, n0 = 32 * nb;
    const int sc0 = map_src_col(maptype, n0);
#pragma unroll 8
    for (int i = 0; i < 32; ++i) { const int kk = 2 * i + (lane >> 5); float v = 0.f;
        if (sc0 >= 0) { v = W[(size_t)(k0 + kk) * Nsrc + sc0 + (lane & 31)]; if (gain) v *= gain[k0 + kk]; }
        scr[kk * 33 + (lane & 31)] = v; }
    LDS_WAIT(); asm volatile("" ::: "memory");
    const int c = lane & 7;
#pragma unroll
    for (int j = 0; j < 4; ++j) { const int n = (lane >> 3) + 8 * j; const LAS float* s = scr + (8 * c) * 33 + n;
        u32x4 o; o.x = cvt_pk_bf16(s[0 * 33], s[1 * 33]); o.y = cvt_pk_bf16(s[2 * 33], s[3 * 33]); o.z = cvt_pk_bf16(s[4 * 33], s[5 * 33]); o.w = cvt_pk_bf16(s[6 * 33], s[7 * 33]);
        *(GAS u32x4*)(WT + (size_t)(n0 + n) * K + k0 + 8 * c) = o; }
    LDS_WAIT(); asm volatile("" ::: "memory");
}
struct ConvJob { const float* W; int K, Nsrc; bf16_t* WT; int Nd; const float* gain; int maptype; };
__device__ __forceinline__ int conv_items(const ConvJob& j) { return (j.K / 64) * (j.Nd / 32); }

__device__ __forceinline__ void rms_row_2048(const float* xrow, bf16_t* orow, int lane) {
    const GAS f32x4* xr = (const GAS f32x4*)xrow + lane;
    f32x4 v[8]; float s = 0.f;
#pragma unroll
    for (int j = 0; j < 8; ++j) { v[j] = xr[64 * j]; s += (v[j].x * v[j].x + v[j].y * v[j].y) + (v[j].z * v[j].z + v[j].w * v[j].w); }
    const float r = 1.0f / sqrtf(wave_sum(s) * (1.f / 2048.f) + EPS);
    GAS u32x2* o = (GAS u32x2*)orow + lane;
#pragma unroll
    for (int j = 0; j < 8; ++j) { u32x2 w; w.x = cvt_pk_bf16(v[j].x * r, v[j].y * r); w.y = cvt_pk_bf16(v[j].z * r, v[j].w * r); o[64 * j] = w; }
}

template <int GL> __device__ __forceinline__ float group_sum(float v) {
#pragma unroll
    for (int o = 1; o < GL; o <<= 1) v += __shfl_xor(v, o);
    return v;
}
template <int GL> __device__ __forceinline__ void norm8_inplace(bf16_t* p, const float* gain8, float scale) {
    bf16x8 x = *(const bf16x8*)p; float f[8], s = 0.f;
#pragma unroll
    for (int j = 0; j < 8; ++j) { f[j] = bf2f(x[j]); s += f[j] * f[j]; }
    s = group_sum<GL>(s); const float r = scale / sqrtf(s * (1.f / (8 * GL)) + EPS);
#pragma unroll
    for (int j = 0; j < 8; ++j) f[j] = f[j] * r * (gain8 ? gain8[j] : 1.f);
    *(u32x4*)p = pack8(f);
}
__device__ __forceinline__ void scale8_inplace(bf16_t* p, float scale) {
    bf16x8 x = *(const bf16x8*)p; float f[8];
#pragma unroll
    for (int j = 0; j < 8; ++j) f[j] = bf2f(x[j]) * scale;
    *(u32x4*)p = pack8(f);
}
__device__ __forceinline__ void norm_rope64(const bf16_t* src, bf16_t* dst, const float* gain8, float scale, float pos, int c) {
    bf16x8 x = *(const bf16x8*)src; float f[8], s = 0.f;
#pragma unroll
    for (int j = 0; j < 8; ++j) { f[j] = bf2f(x[j]); s += f[j] * f[j]; }
    s = group_sum<8>(s); const float r = 1.0f / sqrtf(s * (1.f / 64.f) + EPS);
    float o[8];
#pragma unroll
    for (int j = 0; j < 8; ++j) { f[j] = f[j] * r * gain8[j]; }
#pragma unroll
    for (int j = 0; j < 8; ++j) { const float xp = __shfl_xor(f[j], 4); const int i = 8 * (c & 3) + j;
        const float inv = exp2f(-(float)i * (13.287712379549449f / 32.f));
        float sn, cs; sincosf(pos * inv, &sn, &cs);
        o[j] = (c < 4) ? (f[j] * cs - xp * sn) : (xp * sn + f[j] * cs); o[j] *= scale; }
    *(u32x4*)dst = pack8(o);
}

__device__ __forceinline__ float dot_rows(const bf16_t* q, const bf16_t* k, int n8) {
    float s = 0.f;
    for (int c = 0; c < n8; ++c) { const bf16x8 a = *(const bf16x8*)(q + 8 * c), b = *(const bf16x8*)(k + 8 * c);
#pragma unroll
        for (int j = 0; j < 8; ++j) s += bf2f(a[j]) * bf2f(b[j]); }
    return s;
}
__device__ __forceinline__ void pv_block(float p, const bf16_t* Vb, int ldv, int s0, int smax, int lane, float& o0, float& o1) {
    for (int j = 0; j < 64; ++j) { const float pj = __shfl(p, j); if (pj != 0.f) { int s = s0 + j; s = s > smax ? smax : s;
        const unsigned w = *(const unsigned*)(Vb + (size_t)s * ldv + 2 * lane); o0 += pj * __builtin_bit_cast(float, w << 16); o1 += pj * __builtin_bit_cast(float, w & 0xffff0000u); } }
}
template <int MODE>
__device__ __forceinline__ void simple_query(const bf16_t* q, int nq8, const bf16_t* K, int ldk, const bf16_t* K2, int ldk2, const bf16_t* V, int ldv, bf16_t* orow,
                                             int t, int nk, const float* bias_h  , float sink, int lane) {
    float o0 = 0.f, o1 = 0.f;
    if (MODE == 1) {
        float carry = 0.f;
        for (int kb = (t - 1) >> 6; kb >= 0 && t > 0; --kb) {
            const int s = kb * 64 + lane; const bool valid = s < t; const int sc = valid ? s : 0;
            const float z = dot_rows(q, K + (size_t)sc * ldk, 16);
            const float sp = fmaxf(z, 0.f) + logf(1.f + expf(-fabsf(z)));
            const float lk = valid ? -sp : 0.f, lb = z - sp;
            float x = lk;
#pragma unroll
            for (int off = 1; off < 64; off <<= 1) { const float y = __shfl_down(x, off); x += (lane + off < 64) ? y : 0.f; }
            const float suf = x - lk, tot = __shfl(x, 0);
            const float p = valid ? expf(lb + carry + suf) : 0.f;
            carry += tot;
            pv_block(p, V, ldv, kb * 64, nk - 1, lane, o0, o1);
        }
    } else {
        float m = MODE == 0 ? sink : -1e30f, l = MODE == 0 ? 1.f : 0.f;
        const int lo = MODE == 0 ? (t - 127 > 0 ? t - 127 : 0) : 0, hi = (MODE == 3) ? nk - 1 : t;
        for (int kb = lo >> 6; kb <= (hi >> 6); ++kb) {
            const int s = kb * 64 + lane; const bool valid = s >= lo && s <= hi; const int sc = valid ? s : lo;
            float d = dot_rows(q, K + (size_t)sc * ldk, MODE == 2 ? 16 : nq8);
            if (MODE == 2) d += dot_rows(q + 128, K2 + (size_t)sc * ldk2, 8);
            if (MODE == 0) { const int rel = t - sc; const int n = rel < 0 ? 0 : rel; int bk;
                if (n < 16) bk = n; else { bk = 16 + (int)(logf((float)n / 16.f) / logf(8.f) * 16.f); bk = bk > 31 ? 31 : bk; }
                d += bias_h[bk * 8] * LOG2E; }
            const float scv = valid ? d : -1e30f;
            const float bm = wave_max(scv), mn = fmaxf(m, bm), alpha = exp2f(m - mn);
            const float p = valid ? exp2f(scv - mn) : 0.f;
            l = l * alpha + wave_sum(p); o0 *= alpha; o1 *= alpha; m = mn;
            pv_block(p, V, ldv, kb * 64, nk - 1, lane, o0, o1);
        }
        const float rl = 1.f / l; o0 *= rl; o1 *= rl;
    }
    *(unsigned*)(orow + 2 * lane) = cvt_pk_bf16(o0, o1);
}

struct SchedXkv { pg8::TileOrder T; const char* A; const char* B;
    __device__ bool next(int i, pg8::GUnit& u) const { const long L = (long)i * T.G + T.c; if (L >= 256) return false; const int l = (int)L >> 6, r = (int)L & 63, pm = r >> 2, pn = r & 3;
        u.A = A + (size_t)pm * 256 * DM * 2; u.B = B + (size_t)l * 4 * MiB + (size_t)pn * 256 * DM * 2; u.nt = 32; u.pm = l * 16 + pm; u.pn = pn; u.seg = 0; return true; } };
__device__ __forceinline__ unsigned long long pt_ld(LAS unsigned char* lds, int k) {
    asm volatile("" ::: "memory");
    const unsigned long long v = ((const LAS unsigned long long*)(lds + PT_OFF))[k];
    const unsigned lo = __builtin_amdgcn_readfirstlane((unsigned)v), hi = __builtin_amdgcn_readfirstlane((unsigned)(v >> 32));
    return ((unsigned long long)hi << 32) | lo;
}
#define INP(k) ((const float*)pt_ld(F.lds, (k)))
#define WSP() ((unsigned char*)pt_ld(F.lds, 28))
#define OUTP() ((float*)pt_ld(F.lds, 27))
__global__ void __launch_bounds__(NWAVES * 64, 2) trunk_fwd(Args args) {
    extern __shared__ __attribute__((aligned(16))) unsigned char lds_raw[];
    Frame F;
    F.lds = (LAS unsigned char*)lds_raw;
    volatile LAS unsigned* MISC = (volatile LAS unsigned*)(F.lds + MISC_OFF);
    F.tid = threadIdx.x; F.lane = F.tid & 63; F.wave = __builtin_amdgcn_readfirstlane(F.tid >> 6);
    F.G = gridDim.x; const int bx = blockIdx.x; const int vcu = (F.G % 8 == 0) ? (bx % 8) * (F.G / 8) + bx / 8 : bx;
    F.gw = vcu * NWAVES + F.wave; F.NGW = F.G * NWAVES;
    for (int u = F.tid; u < (LDS_BYTES - LDSCTL_OFF) / 4; u += NWAVES * 64) ((LAS unsigned*)(F.lds + LDSCTL_OFF))[u] = 0u;
    __syncthreads();
    if (F.tid == 0) { LAS unsigned long long* PT = (LAS unsigned long long*)(F.lds + PT_OFF);
#pragma unroll
        for (int k = 0; k < 27; ++k) PT[k] = (unsigned long long)args.in[k];
        PT[27] = (unsigned long long)args.out; PT[28] = (unsigned long long)args.ws; }
    __syncthreads();
    const int lo = args.ph_lo, hi = args.ph_hi;
    const bool use_bar = (hi - lo) > 1;
    XcdBarrier bar; bar.bar = (unsigned*)(WSP() + WS_CTL) + CW_BAR; bar.x = 0; bar.st = nullptr;
    if (use_bar) bar = xcd_barrier_post((unsigned*)(WSP() + WS_CTL) + CW_BAR, MISC + 8);
#define IN(k) (lo <= (k) && (k) < hi)
#define SEAM(k) do { if (IN(k) && IN((k) + 1)) xcd_barrier(bar); } while (0)
#define WSB(off) ((bf16_t*)(ws + (off)))
    LAS float* scr = (LAS float*)(F.lds + F.wave * 16384);

    if (PHON(18) && IN(0)) { int LN = threadIdx.x & 63; asm volatile("" : "+v"(LN));
        unsigned char* ws = WSP();
        for (int l = 0; l < DEPTH; ++l) {
            const int nit = (2048 / 64) * (1024 / 32);
            for (int it = F.gw; it < nit; it += F.NGW)
                transpose_item(INP(20) + (size_t)l * 2048 * 1024, 2048, 1024, WSB(WS_WXKV + (size_t)l * 4 * MiB), 1024 / 32, INP(18) + l * 2048, 0, scr, it, LN);
        }
        const float* mem = INP(1);
        for (int r = F.gw; r < MMEM; r += F.NGW) rms_row_2048(mem + (size_t)r * DM, WSB(WS_MEMN) + (size_t)r * DM, LN);
    }
    SEAM(0);
    if (PHON(19) && IN(1)) { int LN = threadIdx.x & 63; asm volatile("" : "+v"(LN));
        unsigned char* ws = WSP();
        SchedXkv S; S.T.G = F.G; S.T.c = bx; S.A = (const char*)WSB(WS_MEMN); S.B = (const char*)(ws + WS_WXKV);
        pg8::EpiStore E{WSB(WS_XKV), 1024, 0, 0};
        pg8::gemm_phase<pg8::EpiStore, SchedXkv, true, true>(F.lds, DM, DM, S, E);
    }
    SEAM(1);
    if (PHON(20) && IN(2)) { int LN = threadIdx.x & 63; asm volatile("" : "+v"(LN));
        unsigned char* ws = WSP(); const float* g = INP(22);
        for (int r = F.gw; r < DEPTH * MMEM; r += F.NGW) { const int l = r / MMEM; const int h = LN >> 4, c = LN & 15;
            norm8_inplace<16>(WSB(WS_XKV) + (size_t)r * 1024 + h * 256 + c * 8, g + l * 128 + c * 8, 1.f); }
    }
    SEAM(2);

    for (int l = 0; l < DEPTH; ++l) {
        const int P = NPRE + l * NP;
        if (PHON(0) && IN(P + 0)) { int LN = threadIdx.x & 63; asm volatile("" : "+v"(LN));
            unsigned char* ws = WSP(); unsigned char* WL = ws + WS_WL;
#define CJ(wi, K_, Ns_, off_, Nd_, gi, mt) { const int n = ((K_) / 64) * ((Nd_) / 32); if (r >= 0 && r < n) { const float* gn = (gi) >= 0 ? INP((gi) < 0 ? 0 : (gi)) + (size_t)l * (K_) : nullptr; \
                transpose_item(INP(wi) + (size_t)l * (K_) * (Ns_), (K_), (Ns_), (bf16_t*)(WL + (off_)), (Nd_) / 32, gn, (mt), scr, r, LN); } r -= n; }
            constexpr int TOTAL = (2048 / 64) * (LDI / 32) + (2048 / 64) * (2 * DFF / 32) + (DFF / 64) * (2048 / 32) + 2 * (2048 / 64) * (2048 / 32) + (2048 / 64) * (512 / 32) + (512 / 64) * (2048 / 32) + (512 / 64) * (1024 / 32) + (512 / 64) * (768 / 32);
            for (int it = F.gw; it < TOTAL; it += F.NGW) { int r = it;
                CJ(5, 2048, IN_W, WL_IN, LDI, 4, 1)
                CJ(25, 2048, 2 * DFF, WL_GU, 2 * DFF, 24, 2)
                CJ(26, DFF, 2048, WL_DN, 2048, -1, 0)
                CJ(15, 2048, 2048, WL_BR, 2048, -1, 0)
                CJ(16, 2048, 2048, WL_OUT, 2048, -1, 0)
                CJ(19, 2048, 512, WL_XQ, 512, 17, 0)
                CJ(23, 512, 2048, WL_XO, 2048, -1, 0)
                CJ(12, 512, 1024, WL_UKV, 1024, 10, 0)
                CJ(11, 512, 768, WL_UQ, 768, 9, 0)
            }
#undef CJ
            const float* xcur = (l == 0) ? INP(0) : OUTP();
            for (int r = F.gw; r < M; r += F.NGW) rms_row_2048(xcur + (size_t)r * DM, WSB(WS_XN) + (size_t)r * DM, LN);
        }
        SEAM(P + 0);
        if (PHON(1) && IN(P + 1)) { int LN = threadIdx.x & 63; asm volatile("" : "+v"(LN));
            unsigned char* ws = WSP();
            pg8::SchedSimple S; S.init(WSB(WS_XN), DM, WSB(WS_WL + WL_IN), DM, M, LDI, DM, F.G, bx);
            pg8::EpiStore E{WSB(WS_IN), LDI, C_G / 256, C_KR / 256};
            pg8::gemm_phase<pg8::EpiStore, pg8::SchedSimple, true, true>(F.lds, DM, DM, S, E);
        }
        SEAM(P + 1);
        if (PHON(2) && IN(P + 2)) { int LN = threadIdx.x & 63; asm volatile("" : "+v"(LN));
            unsigned char* ws = WSP(); bf16_t* INb = WSB(WS_IN); bf16_t* KR = WSB(WS_KR); const int* positions = (const int*)INP(2);
            const float* gq = INP(6) + l * 128; const float* gk = INP(7) + l * 128; const float* kg = INP(14) + l * 192;
            for (int r = F.gw; r < M; r += F.NGW) { bf16_t* row = INb + (size_t)r * LDI; const int c16 = LN & 15;
#pragma unroll
                for (int ps = 0; ps < 2; ++ps) norm8_inplace<16>(row + C_QA + (ps * 4 + (LN >> 4)) * 128 + c16 * 8, gq + c16 * 8, 0.08838834764831845f * LOG2E);
                if (LN < 32) norm8_inplace<16>(row + C_KA + (LN >> 4) * 128 + c16 * 8, gk + c16 * 8, 1.f);
                scale8_inplace(row + C_QB + LN * 8, 0.08838834764831845f);
                norm8_inplace<64>(row + C_CQ + LN * 8, nullptr, 1.f);
                norm8_inplace<64>(row + C_CKV + LN * 8, nullptr, 1.f);
                if (LN < 8) norm_rope64(row + C_KR + LN * 8, KR + (size_t)r * 64 + LN * 8, kg + 128 + LN * 8, 1.f, (float)positions[r], LN);
            }
        }
        SEAM(P + 2);
        if (PHON(3) && IN(P + 3)) { int LN = threadIdx.x & 63; asm volatile("" : "+v"(LN));
            unsigned char* ws = WSP();
            { pg8::SchedSimple S; S.init(WSB(WS_IN) + C_CQ, LDI, WSB(WS_WL + WL_UQ), 512, M, 768, 512, F.G, F.G - 1 - bx);
              pg8::EpiStore E{WSB(WS_QC), 768, 0, 0};
              pg8::gemm_phase<pg8::EpiStore, pg8::SchedSimple, true, true>(F.lds, LDI, 512, S, E); }
            { pg8::SchedSimple S; S.init(WSB(WS_IN) + C_CKV, LDI, WSB(WS_WL + WL_UKV), 512, M, 1024, 512, F.G, bx);
              pg8::EpiStore E{WSB(WS_KVC), 1024, 0, 0};
              pg8::gemm_phase<pg8::EpiStore, pg8::SchedSimple, true, true>(F.lds, LDI, 512, S, E); }
        }
        SEAM(P + 3);
        if (PHON(4) && IN(P + 4)) { int LN = threadIdx.x & 63; asm volatile("" : "+v"(LN));
            unsigned char* ws = WSP(); bf16_t* QC = WSB(WS_QC); bf16_t* KVC = WSB(WS_KVC); const int* positions = (const int*)INP(2);
            const float* qg = INP(13) + l * 192; const float* kg = INP(14) + l * 192; const float qs = 0.07216878364870323f * LOG2E;
            for (int r = F.gw; r < M; r += F.NGW) { const int h = LN >> 4, c = LN & 15;
                norm8_inplace<16>(QC + (size_t)r * 768 + h * 192 + c * 8, qg + c * 8, qs);
                norm8_inplace<16>(KVC + (size_t)r * 1024 + h * 256 + c * 8, kg + c * 8, 1.f);
                if (c < 8) { bf16_t* p = QC + (size_t)r * 768 + h * 192 + 128 + c * 8; norm_rope64(p, p, qg + 128 + c * 8, qs, (float)positions[r], c); }
            }
        }
        SEAM(P + 4);
        if (PHON(5) && IN(P + 5)) { int LN = threadIdx.x & 63; asm volatile("" : "+v"(LN));
            unsigned char* ws = WSP(); const bf16_t* INb = WSB(WS_IN); bf16_t* OCAT = WSB(WS_XN); const float* rel_bias = INP(3); const float* sinks = INP(8) + l * 8;
            for (int qi = F.gw; qi < M * 8; qi += F.NGW) { const int h = qi & 7, r = qi >> 3, b = r / SEQ, t = r % SEQ;
                const bf16_t* Kb = INb + (size_t)b * SEQ * LDI + C_KA + (h >> 2) * 128; const bf16_t* Vb = INb + (size_t)b * SEQ * LDI + C_VA + (h >> 2) * 128;
                simple_query<0>(INb + (size_t)r * LDI + C_QA + h * 128, 16, Kb, LDI, nullptr, 0, Vb, LDI, OCAT + (size_t)r * DM + h * 128, t, SEQ, rel_bias + h, sinks[h] * LOG2E, LN); }
        }
        SEAM(P + 5);
        if (PHON(6) && IN(P + 6)) { int LN = threadIdx.x & 63; asm volatile("" : "+v"(LN));
            unsigned char* ws = WSP(); const bf16_t* INb = WSB(WS_IN); bf16_t* OCAT = WSB(WS_XN);
            for (int qi = F.gw; qi < M * 4; qi += F.NGW) { const int h = qi & 3, r = qi >> 2, b = r / SEQ, t = r % SEQ;
                const bf16_t* Kb = INb + (size_t)b * SEQ * LDI + C_KB + h * 128; const bf16_t* Vb = INb + (size_t)b * SEQ * LDI + C_VB + h * 128;
                simple_query<1>(INb + (size_t)r * LDI + C_QB + h * 128, 16, Kb, LDI, nullptr, 0, Vb, LDI, OCAT + (size_t)r * DM + 1024 + h * 128, t, SEQ, nullptr, 0.f, LN); }
        }
        SEAM(P + 6);
        if (PHON(7) && IN(P + 7)) { int LN = threadIdx.x & 63; asm volatile("" : "+v"(LN));
            unsigned char* ws = WSP(); const bf16_t* QC = WSB(WS_QC); const bf16_t* KVC = WSB(WS_KVC); const bf16_t* KR = WSB(WS_KR); bf16_t* OCAT = WSB(WS_XN);
            for (int qi = F.gw; qi < M * 4; qi += F.NGW) { const int h = qi & 3, r = qi >> 2, b = r / SEQ, t = r % SEQ;
                const bf16_t* Kb = KVC + (size_t)b * SEQ * 1024 + h * 256; const bf16_t* K2b = KR + (size_t)b * SEQ * 64; const bf16_t* Vb = Kb + 128;
                simple_query<2>(QC + (size_t)r * 768 + h * 192, 24, Kb, 1024, K2b, 64, Vb, 1024, OCAT + (size_t)r * DM + 1536 + h * 128, t, SEQ, nullptr, 0.f, LN); }
        }
        SEAM(P + 7);
        if (PHON(8) && IN(P + 8)) { int LN = threadIdx.x & 63; asm volatile("" : "+v"(LN));
            unsigned char* ws = WSP();
            pg8::SchedBranch S; S.init(WSB(WS_XN), WSB(WS_WL + WL_BR), F.G, bx);
            pg8::EpiBranch E{WSB(WS_IN) + C_G, WSB(WS_MRG)};
            pg8::gemm_phase<pg8::EpiBranch, pg8::SchedBranch, true, true>(F.lds, DM, DM, S, E);
        }
        SEAM(P + 8);
        if (PHON(9) && IN(P + 9)) { int LN = threadIdx.x & 63; asm volatile("" : "+v"(LN));
            unsigned char* ws = WSP();
            pg8::SchedSimple S; S.init(WSB(WS_MRG), DM, WSB(WS_WL + WL_OUT), DM, M, DM, DM, F.G, bx);
            pg8::EpiRes E{(l == 0) ? INP(0) : OUTP(), OUTP()};
            pg8::gemm_phase<pg8::EpiRes, pg8::SchedSimple, true, true>(F.lds, DM, DM, S, E);
        }
        SEAM(P + 9);
        if (PHON(10) && IN(P + 10)) { int LN = threadIdx.x & 63; asm volatile("" : "+v"(LN)); unsigned char* ws = WSP(); const float* xr = OUTP(); for (int r = F.gw; r < M; r += F.NGW) rms_row_2048(xr + (size_t)r * DM, WSB(WS_XN) + (size_t)r * DM, LN); }
        SEAM(P + 10);
        if (PHON(11) && IN(P + 11)) { int LN = threadIdx.x & 63; asm volatile("" : "+v"(LN));
            unsigned char* ws = WSP();
            pg8::SchedSimple S; S.init(WSB(WS_XN), DM, WSB(WS_WL + WL_XQ), DM, M, 512, DM, F.G, bx);
            pg8::EpiStore E{WSB(WS_XQ), 512, 0, 0};
            pg8::gemm_phase<pg8::EpiStore, pg8::SchedSimple, true, true>(F.lds, DM, DM, S, E);
        }
        SEAM(P + 11);
        if (PHON(12) && IN(P + 12)) { int LN = threadIdx.x & 63; asm volatile("" : "+v"(LN));
            unsigned char* ws = WSP(); bf16_t* XQ = WSB(WS_XQ); const float* g = INP(21) + l * 128;
            for (int r = F.gw; r < M; r += F.NGW) { const int h = LN >> 4, c = LN & 15; norm8_inplace<16>(XQ + (size_t)r * 512 + h * 128 + c * 8, g + c * 8, 0.08838834764831845f * LOG2E); }
        }
        SEAM(P + 12);
        if (PHON(13) && IN(P + 13)) { int LN = threadIdx.x & 63; asm volatile("" : "+v"(LN));
            unsigned char* ws = WSP(); const bf16_t* XQ = WSB(WS_XQ); bf16_t* XO = WSB(WS_XO);
            const bf16_t* XKVl = WSB(WS_XKV) + (size_t)l * MMEM * 1024;
            for (int qi = F.gw; qi < M * 4; qi += F.NGW) { const int h = qi & 3, r = qi >> 2, b = r / SEQ;
                const bf16_t* Kb = XKVl + (size_t)b * MEMLEN * 1024 + h * 256;
                simple_query<3>(XQ + (size_t)r * 512 + h * 128, 16, Kb, 1024, nullptr, 0, Kb + 128, 1024, XO + (size_t)r * 512 + h * 128, 0, MEMLEN, nullptr, 0.f, LN); }
        }
        SEAM(P + 13);
        if (PHON(14) && IN(P + 14)) { int LN = threadIdx.x & 63; asm volatile("" : "+v"(LN));
            unsigned char* ws = WSP();
            pg8::SchedSimple S; S.init(WSB(WS_XO), 512, WSB(WS_WL + WL_XO), 512, M, DM, 512, F.G, bx);
            pg8::EpiRes E{OUTP(), OUTP()};
            pg8::gemm_phase<pg8::EpiRes, pg8::SchedSimple, true, true>(F.lds, 512, 512, S, E);
        }
        SEAM(P + 14);
        if (PHON(15) && IN(P + 15)) { int LN = threadIdx.x & 63; asm volatile("" : "+v"(LN)); unsigned char* ws = WSP(); const float* xr = OUTP(); for (int r = F.gw; r < M; r += F.NGW) rms_row_2048(xr + (size_t)r * DM, WSB(WS_XN) + (size_t)r * DM, LN); }
        SEAM(P + 15);
        if (PHON(16) && IN(P + 16)) { int LN = threadIdx.x & 63; asm volatile("" : "+v"(LN));
            unsigned char* ws = WSP();
            pg8::SchedSimple S; S.init(WSB(WS_XN), DM, WSB(WS_WL + WL_GU), DM, M, 2 * DFF, DM, F.G, bx);
            pg8::EpiSwiglu E{WSB(WS_IN)};
            pg8::gemm_phase<pg8::EpiSwiglu, pg8::SchedSimple, true, true>(F.lds, DM, DM, S, E);
        }
        SEAM(P + 16);
        if (PHON(17) && IN(P + 17)) { int LN = threadIdx.x & 63; asm volatile("" : "+v"(LN));
            unsigned char* ws = WSP();
            pg8::SchedSimple S; S.init(WSB(WS_IN), DFF, WSB(WS_WL + WL_DN), DFF, M, DM, DFF, F.G, bx);
            pg8::EpiRes E{OUTP(), OUTP()};
            pg8::gemm_phase<pg8::EpiRes, pg8::SchedSimple, true, true>(F.lds, DFF, DFF, S, E);
        }
        SEAM(P + 17);
    }
#undef IN
#undef SEAM
#undef WSB
}

extern "C" void kernel_launch(void* const* d_in, const int* in_sizes, int n_in, void* d_out, int out_size, void* d_ws, size_t ws_size, hipStream_t stream) {
    static int grid = 0;
    if (grid == 0) {
        if (n_in != 27 || out_size != M * DM || ws_size < WS_END) { fprintf(stderr, "kernel_launch: unexpected shapes: n_in %d out %d ws %zu (need %zu)\n", n_in, out_size, ws_size, (size_t)WS_END); grid = -1; return; }
        int dev = 0, cus = 0;
        if (hipGetDevice(&dev) != hipSuccess || hipDeviceGetAttribute(&cus, hipDeviceAttributeMultiprocessorCount, dev) != hipSuccess) { grid = -1; return; }
        if (hipFuncSetAttribute((const void*)trunk_fwd, hipFuncAttributeMaxDynamicSharedMemorySize, LDS_BYTES) != hipSuccess) { fprintf(stderr, "kernel_launch: hipFuncSetAttribute failed\n"); grid = -1; return; }
        int per_cu = 0;
        if (hipOccupancyMaxActiveBlocksPerMultiprocessor(&per_cu, (const void*)trunk_fwd, NWAVES * 64, LDS_BYTES) != hipSuccess || per_cu < 1) fprintf(stderr, "kernel_launch: occupancy query says %d\n", per_cu);
        (void)hipGetLastError();
        grid = cus;
    }
    if (grid < 0) return;
    (void)hipMemsetAsync((char*)d_ws + WS_CTL, 0, CTL_ZERO_BYTES, stream);
    Args a{};
    for (int i = 0; i < 27; ++i) a.in[i] = (const float*)d_in[i];
    a.pos = (const int*)d_in[2]; a.out = (float*)d_out; a.ws = (unsigned char*)d_ws;
#if MK_ONE_LAUNCH
    a.ph_lo = 0; a.ph_hi = NPHASE;
    hipLaunchKernelGGL(trunk_fwd, dim3(grid), dim3(NWAVES * 64), LDS_BYTES, stream, a);
#else
    for (int p = 0; p < NPHASE; ++p) { a.ph_lo = p; a.ph_hi = p + 1; hipLaunchKernelGGL(trunk_fwd, dim3(grid), dim3(NWAVES * 64), LDS_BYTES, stream, a); }
#endif
    const hipError_t le = hipPeekAtLastError();
    if (le != hipSuccess) fprintf(stderr, "kernel_launch: launch failed: %s\n", hipGetErrorName(le));
}
```

```cpp
#include <hip/hip_runtime.h>
#include <cstdio>
#include <cstdint>

#ifndef PHASE_MASK
#define PHASE_MASK 0xFFFFFFFFull
#endif
#define PHON(k) (((PHASE_MASK) >> (k)) & 1ull)
#ifndef ATT_MFMA
#define ATT_MFMA 0xF
#endif
#ifndef PROBE_SET
#define PROBE_SET 0ull
#endif
#ifndef MK_ONE_LAUNCH
#define MK_ONE_LAUNCH 1
#endif

#define GAS __attribute__((address_space(1)))
#define LAS __attribute__((address_space(3)))
typedef unsigned short bf16_t;
typedef short bf16x8 __attribute__((ext_vector_type(8)));
typedef _Float16 f16_t;
typedef _Float16 f16x8 __attribute__((ext_vector_type(8)));
typedef short s16x4 __attribute__((ext_vector_type(4)));
typedef float f32x2 __attribute__((ext_vector_type(2)));
typedef float f32x4 __attribute__((ext_vector_type(4)));
typedef float f32x16 __attribute__((ext_vector_type(16)));
typedef unsigned u32x2 __attribute__((ext_vector_type(2)));
typedef unsigned u32x4 __attribute__((ext_vector_type(4)));
typedef GAS unsigned gu32;

constexpr int BATCH = 16, SEQ = 2048, DM = 2048, M = BATCH * SEQ, DEPTH = 4;
constexpr int MEMLEN = 256, MMEM = BATCH * MEMLEN;
constexpr int IN_W = 10304, LDI = 10496;
constexpr int DFF = 5632;
constexpr float EPS = 1e-6f;
constexpr float LOG2E = 1.4426950408889634f;
constexpr int C_QA = 0, C_KA = 1024, C_VA = 1280, C_QB = 1536, C_KB = 2048, C_VB = 2560, C_CQ = 3072, C_CKV = 3584, C_G = 4096, C_KR = 10240;
constexpr int NP = 15;
constexpr int NPRE = 3;
constexpr int NPHASE = NPRE + DEPTH * NP;

constexpr size_t MiB = 1u << 20;
constexpr size_t WS_CTL = 0, CTL_ZERO_BYTES = 1 * MiB;
constexpr size_t WS_TAB = 1 * MiB;
constexpr size_t WS_WL = 2 * MiB;
constexpr size_t WL_IN = 0, WL_GU = 41 * MiB, WL_DN = 85 * MiB, WL_BR = 107 * MiB, WL_OUT = 115 * MiB, WL_XQ = 123 * MiB, WL_XO = 125 * MiB, WL_UKV = 127 * MiB, WL_UQ = 128 * MiB;
constexpr size_t WS_WXKV = 132 * MiB;
constexpr size_t WS_IN = 148 * MiB;
constexpr size_t WS_XN = 804 * MiB;
constexpr size_t WS_X16 = 932 * MiB;
constexpr size_t WS_QC = 1060 * MiB;
constexpr size_t WS_KVC = 1108 * MiB;
constexpr size_t WS_KR = 1172 * MiB;
constexpr size_t WS_MEMN = 1176 * MiB;
constexpr size_t WS_XKV = 1192 * MiB;
constexpr size_t WS_XQ = WS_IN + 416 * MiB;
constexpr size_t WS_KA = 1224 * MiB, WS_VA = 1240 * MiB;
constexpr size_t WS_XO = 1256 * MiB;
constexpr size_t WS_ROPE = 1288 * MiB;
constexpr size_t WS_SS = 1296 * MiB;
constexpr size_t WS_KR2 = 1300 * MiB;
constexpr size_t WS_KB = 1316 * MiB, WS_VB = 1348 * MiB;
constexpr size_t WS_RS = 1380 * MiB;
constexpr size_t WS_END = 1381 * MiB;
static_assert(WS_IN + (size_t)M * LDI * 2 <= WS_XN && WL_UQ + 768 * 512 * 2 <= 130 * MiB, "ws map");

constexpr int RING_BYTES = 131072;
constexpr int LDSCTL_OFF = RING_BYTES, MISC_OFF = LDSCTL_OFF + 320, PT_OFF = LDSCTL_OFF + 1024;
constexpr int RS_LDS_OFF = LDSCTL_OFF + 10240;
constexpr int LDS_BYTES = 147456;
constexpr int NWAVES = 8;

#define RLX_AGENT __ATOMIC_RELAXED, __HIP_MEMORY_SCOPE_AGENT
#define LDS_WAIT() asm volatile("s_waitcnt lgkmcnt(0)" ::: "memory")
#define VM_WAIT() asm volatile("s_waitcnt vmcnt(0)" ::: "memory")
__device__ __forceinline__ unsigned cvt_pk_bf16(float lo, float hi) { unsigned r; asm volatile("v_cvt_pk_bf16_f32 %0, %1, %2" : "=v"(r) : "v"(lo), "v"(hi)); return r; }
__device__ __forceinline__ float bf2f(short h) { return __builtin_bit_cast(float, ((unsigned)(unsigned short)h) << 16); }
__device__ __forceinline__ float wave_sum(float v) {
#pragma unroll
    for (int o = 1; o < 64; o <<= 1) v += __shfl_xor(v, o);
    return v;
}
__device__ __forceinline__ float wave_max(float v) {
#pragma unroll
    for (int o = 1; o < 64; o <<= 1) v = fmaxf(v, __shfl_xor(v, o));
    return v;
}
__device__ __forceinline__ float fast_exp2(float x) { return __builtin_amdgcn_exp2f(x); }
__device__ __forceinline__ float fast_rcp(float x) { return __builtin_amdgcn_rcpf(x); }
__device__ __forceinline__ float sigmoidf_(float z) { return fast_rcp(1.f + fast_exp2(-z * LOG2E)); }
__device__ __forceinline__ u32x4 pack8(const float* v) { u32x4 w; w.x = cvt_pk_bf16(v[0], v[1]); w.y = cvt_pk_bf16(v[2], v[3]); w.z = cvt_pk_bf16(v[4], v[5]); w.w = cvt_pk_bf16(v[6], v[7]); return w; }

namespace pg8 {
constexpr int BM = 256, BK = 64, HALF = 128, HTB = HALF * BK * 2, NXCD = 8, WGM = 4;
__host__ __device__ __forceinline__ int lds_byte(int r, int c) { const int st = (r >> 4) * 2 + (c >> 5), rr = r & 15, cc = c & 31, ob = rr * 64 + cc * 2; return st * 1024 + (ob ^ (((ob >> 9) & 1) << 5)); }
__host__ __device__ __forceinline__ void stage_rc(int b, int& R, int& C) { const int st = b / 1024, sb = b % 1024, swz = sb ^ (((sb >> 9) & 1) << 5); R = (st >> 1) * 16 + swz / 64; C = (st & 1) * 32 + (swz % 64) / 2; }
__host__ __device__ __forceinline__ int perm32(int rho) { const int n = rho >> 4, i = rho & 15; return 8 * (i >> 2) + 4 * n + (i & 3); }

struct GUnit { const char* A; const char* B; int nt; int pm, pn, seg; };

struct TileOrder {
    int nM, nN, nwg, G, c;
    __device__ void init(int nM_, int nN_, int G_, int c_) { nM = nM_; nN = nN_; nwg = nM * nN; G = G_; c = c_; }
    __device__ bool tile(int i, int& pm, int& pn) const {
        const long L = (long)i * G + c; if (L >= nwg) return false;
        int wgid = (int)L; { const int q = nwg / NXCD, r = nwg % NXCD, xcd = wgid % NXCD, off = wgid / NXCD; wgid = (xcd < r ? xcd * (q + 1) : r * (q + 1) + (xcd - r) * q) + off; }
        const int nig = WGM * nN, gid = wgid / nig, fm = gid * WGM, gsz = (nM - fm) < WGM ? (nM - fm) : WGM;
        pm = fm + ((wgid % nig) % gsz); pn = (wgid % nig) / gsz; return true;
    }
};
struct SchedSimple {
    TileOrder T; const char* A; const char* B; size_t tA, tB; int nt;
    __device__ void init(const bf16_t* A_, int lda, const bf16_t* B_, int ldb, int Mr, int N, int K, int G, int c) { T.init(Mr / BM, N / BM, G, c); A = (const char*)A_; B = (const char*)B_; tA = (size_t)BM * lda * 2; tB = (size_t)BM * ldb * 2; nt = K / BK; }
    __device__ bool next(int i, GUnit& u) const { int pm, pn; if (!T.tile(i, pm, pn)) return false; u.A = A + pm * tA; u.B = B + pn * tB; u.nt = nt; u.pm = pm; u.pn = pn; u.seg = 0; return true; }
};
struct SchedIn {
    TileOrder T; const char* A; const char* B; size_t tA, tB;
    __device__ void init(const bf16_t* A_, const bf16_t* B_, int G, int c) { T.init(M / BM, 40, G, c); A = (const char*)A_; B = (const char*)B_; tA = (size_t)BM * DM * 2; tB = (size_t)BM * DM * 2; }
    __device__ bool next(int i, GUnit& u) const { int pm, pn;
        if (T.tile(i, pm, pn)) { u.A = A + pm * tA; u.B = B + pn * tB; u.nt = 32; u.pm = pm; u.pn = pn; u.seg = 0; return true; }
        const long hu = (long)i * T.G + T.c - T.nwg; if (hu < 0 || hu >= 256) return false;
        const int kh = (int)hu & 1; pm = (int)hu >> 1; u.A = A + pm * tA + kh * 2048; u.B = B + 40 * tB + kh * 2048; u.nt = 16; u.pm = pm; u.pn = 40 + kh; u.seg = 0; return true; }
};
struct SchedBranch {
    TileOrder T; const char* A; const char* B; size_t tA, tB;
    __device__ void init(const bf16_t* A_, const bf16_t* B_, int G, int c) { T.init(M / BM, DM / BM, G, c); A = (const char*)A_; B = (const char*)B_; tA = (size_t)BM * DM * 2; tB = (size_t)BM * DM * 2; }
    __device__ bool next(int i, GUnit& u) const { int pm, pn; const int ti = i / 3, seg = i - 3 * ti; if (!T.tile(ti, pm, pn)) return false;
        const int koff = seg == 0 ? 0 : (seg == 1 ? 1024 : 1536); u.A = A + pm * tA + koff * 2; u.B = B + pn * tB + koff * 2; u.nt = seg == 0 ? 16 : 8; u.pm = pm; u.pn = pn; u.seg = seg; return true; }
};

__device__ __forceinline__ void row_scales(const float* SS, int row0, int fq, float (&rs)[2][4]) {
    f32x4 pa_[2][4], pb_[2][4];
#pragma unroll
    for (int ai = 0; ai < 2; ++ai)
#pragma unroll
        for (int m = 0; m < 4; ++m) { const float* p = SS + (size_t)(row0 + ai * HALF + m * 16) * 32 + fq * 8; pa_[ai][m] = *(const GAS f32x4*)p; pb_[ai][m] = *(const GAS f32x4*)(p + 4); }
    __builtin_amdgcn_sched_barrier(0);
#pragma unroll
    for (int ai = 0; ai < 2; ++ai)
#pragma unroll
        for (int m = 0; m < 4; ++m) { const f32x4 a = pa_[ai][m], b = pb_[ai][m];
            float s = (a[0] + a[1]) + (a[2] + a[3]) + (b[0] + b[1]) + (b[2] + b[3]); s += __shfl_xor(s, 16); s += __shfl_xor(s, 32);
            rs[ai][m] = 1.0f / sqrtf(s * (1.f / 2048.f) + EPS); }
}
struct EpiStore {
    bf16_t* O; int ldc; int sig_lo, sig_hi; const float* SS; int hm = 0; const float* RS = nullptr;
    __device__ __forceinline__ bf16_t* hm_dest(int pn, int bj, int row, int c128) const {
        char* ob = (char*)O;
        if (hm == 1) { const int b = row >> 11, s = row & (SEQ - 1);
            if (pn == 4) return (bf16_t*)(ob + (WS_KA - WS_IN)) + ((size_t)(b * 2 + bj) * SEQ + s) * 128 + c128;
            if (pn == 5) return (bf16_t*)(ob + (WS_VA - WS_IN)) + ((size_t)(b * 2 + bj) * SEQ + s) * 128 + c128;
            if (pn == 8 || pn == 9) return (bf16_t*)(ob + (WS_KB - WS_IN)) + ((size_t)(b * 4 + (pn - 8) * 2 + bj) * SEQ + s) * 128 + c128;
            if (pn == 10 || pn == 11) return (bf16_t*)(ob + (WS_VB - WS_IN)) + ((size_t)(b * 4 + (pn - 10) * 2 + bj) * SEQ + s) * 128 + c128;
            return nullptr; }
        if (hm == 2) { const int b = row >> 11, s = row & (SEQ - 1); return (bf16_t*)(ob + (bj == 0 ? 0 : 32 * MiB)) + ((size_t)(b * 4 + pn) * SEQ + s) * 128 + c128; }
        if (hm == 3) { const int l = row >> 12, b = (row >> 8) & 15, s = row & 255; return O + ((size_t)(((l * 16 + b) * 4 + pn) * 2 + bj) * 256 + s) * 128 + c128; }
        return nullptr;
    }
    __device__ __forceinline__ bool operator()(f32x4 (&acc)[2][2][4][2], const GUnit& u, int wr, int wc, int fr, int fq, const float (&prs)[2][4]) const {
        const int row0 = u.pm * BM + wr * 64 + fr, col0 = u.pn * BM + wc * 32 + 8 * fq; const bool sig = u.pn >= sig_lo && u.pn < sig_hi;
        float rs[2][4];
        if (SS) row_scales(SS, row0, fq, rs);
        else if (RS) {
#pragma unroll
            for (int ai = 0; ai < 2; ++ai)
#pragma unroll
                for (int m = 0; m < 4; ++m) rs[ai][m] = prs[ai][m]; }
#pragma unroll
        for (int ai = 0; ai < 2; ++ai)
#pragma unroll
            for (int m = 0; m < 4; ++m) { bf16_t* rowp = (u.pn == 41) ? (bf16_t*)((char*)O + (WS_KR2 - WS_IN)) + (size_t)(row0 + ai * HALF + m * 16) * 256 + wc * 32 + 8 * fq : O + (size_t)(row0 + ai * HALF + m * 16) * ldc + col0;
#pragma unroll
                for (int bj = 0; bj < 2; ++bj) { float v[8];
#pragma unroll
                    for (int j = 0; j < 4; ++j) { v[j] = acc[ai][bj][m][0][j]; v[4 + j] = acc[ai][bj][m][1][j]; }
                    if (SS || RS) {
#pragma unroll
                        for (int j = 0; j < 8; ++j) v[j] *= rs[ai][m]; }
                    if (sig) {
#pragma unroll
                        for (int j = 0; j < 8; ++j) v[j] = fmaxf(sigmoidf_(v[j]), 1e-18f); }
                    bf16_t* hd = hm ? hm_dest(u.pn, bj, row0 + ai * HALF + m * 16, wc * 32 + 8 * fq) : nullptr;
                    if (hd) *(GAS u32x4*)hd = pack8(v); else *(GAS u32x4*)(rowp + bj * HALF) = pack8(v); } }
        return true;
    }
};
struct EpiRes {
    const float* base; float* out;
    __device__ __forceinline__ bool operator()(f32x4 (&acc)[2][2][4][2], const GUnit& u, int wr, int wc, int fr, int fq) const {
        const int row0 = u.pm * BM + wr * 64 + fr, col0 = u.pn * BM + wc * 32 + 8 * fq;
#pragma unroll
        for (int ai = 0; ai < 2; ++ai) { f32x4 bv[4][2][2];
#pragma unroll
            for (int m = 0; m < 4; ++m) { const size_t off = (size_t)(row0 + ai * HALF + m * 16) * DM + col0;
#pragma unroll
                for (int bj = 0; bj < 2; ++bj)
#pragma unroll
                    for (int n = 0; n < 2; ++n) bv[m][bj][n] = *(const GAS f32x4*)(base + off + bj * HALF + 4 * n); }
            __builtin_amdgcn_sched_barrier(0);
#pragma unroll
            for (int m = 0; m < 4; ++m) { const size_t off = (size_t)(row0 + ai * HALF + m * 16) * DM + col0;
#pragma unroll
                for (int bj = 0; bj < 2; ++bj)
#pragma unroll
                    for (int n = 0; n < 2; ++n) *(GAS f32x4*)(out + off + bj * HALF + 4 * n) = bv[m][bj][n] + acc[ai][bj][m][n]; }
            __builtin_amdgcn_sched_barrier(0); }
        return true;
    }
};
struct EpiResX {
    f16_t* X16; float* SS;
    __device__ __forceinline__ bool operator()(f32x4 (&acc)[2][2][4][2], const GUnit& u, int wr, int wc, int fr, int fq) const {
        const int row0 = u.pm * BM + wr * 64 + fr, col0 = u.pn * BM + wc * 32 + 8 * fq;
#pragma unroll
        for (int ai = 0; ai < 2; ++ai) { f16x8 bv[4][2];
#pragma unroll
            for (int m = 0; m < 4; ++m) { const size_t off = (size_t)(row0 + ai * HALF + m * 16) * DM + col0;
#pragma unroll
                for (int bj = 0; bj < 2; ++bj) bv[m][bj] = *(const GAS f16x8*)(X16 + off + bj * HALF); }
            __builtin_amdgcn_sched_barrier(0);
#pragma unroll
            for (int m = 0; m < 4; ++m) { const int row = row0 + ai * HALF + m * 16; const size_t off = (size_t)row * DM + col0; float s = 0.f;
#pragma unroll
                for (int bj = 0; bj < 2; ++bj) { f16x8 h;
#pragma unroll
                    for (int n = 0; n < 2; ++n)
#pragma unroll
                        for (int j = 0; j < 4; ++j) { const float x = (float)bv[m][bj][4 * n + j] + acc[ai][bj][m][n][j]; h[4 * n + j] = (f16_t)x; s += x * x; }
                    *(GAS f16x8*)(X16 + off + bj * HALF) = h; }
                s += __shfl_xor(s, 16); s += __shfl_xor(s, 32);
                if (fq == 0) ((GAS float*)SS)[(size_t)row * 32 + u.pn * 4 + wc] = s; }
            __builtin_amdgcn_sched_barrier(0); }
        return true;
    }
};
struct EpiResF {
    const f16_t* X16; float* out;
    __device__ __forceinline__ bool operator()(f32x4 (&acc)[2][2][4][2], const GUnit& u, int wr, int wc, int fr, int fq) const {
        const int row0 = u.pm * BM + wr * 64 + fr, col0 = u.pn * BM + wc * 32 + 8 * fq;
#pragma unroll
        for (int ai = 0; ai < 2; ++ai) { f16x8 bv[4][2];
#pragma unroll
            for (int m = 0; m < 4; ++m) { const size_t off = (size_t)(row0 + ai * HALF + m * 16) * DM + col0;
#pragma unroll
                for (int bj = 0; bj < 2; ++bj) bv[m][bj] = *(const GAS f16x8*)(X16 + off + bj * HALF); }
            __builtin_amdgcn_sched_barrier(0);
#pragma unroll
            for (int m = 0; m < 4; ++m) { const size_t off = (size_t)(row0 + ai * HALF + m * 16) * DM + col0;
#pragma unroll
                for (int bj = 0; bj < 2; ++bj)
#pragma unroll
                    for (int n = 0; n < 2; ++n) { f32x4 x;
#pragma unroll
                        for (int j = 0; j < 4; ++j) x[j] = (float)bv[m][bj][4 * n + j] + acc[ai][bj][m][n][j];
                        *(GAS f32x4*)(out + off + bj * HALF + 4 * n) = x; } }
            __builtin_amdgcn_sched_barrier(0); }
        return true;
    }
};
struct EpiUkv {
    bf16_t* O; const float* kg; LAS float* xs;
    __device__ __forceinline__ bool operator()(f32x4 (&acc)[2][2][4][2], const GUnit& u, int wr, int wc, int fr, int fq) const {
        const int row0 = u.pm * BM + wr * 64 + fr, c128 = wc * 32 + 8 * fq;
#pragma unroll
        for (int ai = 0; ai < 2; ++ai)
#pragma unroll
            for (int m = 0; m < 4; ++m) { float s = 0.f;
#pragma unroll
                for (int n = 0; n < 2; ++n)
#pragma unroll
                    for (int j = 0; j < 4; ++j) { const float x = acc[ai][0][m][n][j]; s += x * x; }
                s += __shfl_xor(s, 16); s += __shfl_xor(s, 32);
                if (fq == 0) xs[(ai * HALF + wr * 64 + m * 16 + fr) * 4 + wc] = s; }
        asm volatile("s_waitcnt lgkmcnt(0)" ::: "memory"); __builtin_amdgcn_s_barrier(); asm volatile("" ::: "memory");
        const f32x4 g0 = *(const GAS f32x4*)(kg + c128), g1 = *(const GAS f32x4*)(kg + c128 + 4);
#pragma unroll
        for (int ai = 0; ai < 2; ++ai)
#pragma unroll
            for (int m = 0; m < 4; ++m) { const f32x4 p = *(const LAS f32x4*)(xs + (ai * HALF + wr * 64 + m * 16 + fr) * 4);
                const float r = 1.0f / sqrtf(((p[0] + p[1]) + (p[2] + p[3])) * (1.f / 128.f) + EPS);
                const int row = row0 + ai * HALF + m * 16, b = row >> 11, s = row & (SEQ - 1);
                bf16_t* kd = O + ((size_t)(b * 4 + u.pn) * SEQ + s) * 128 + c128; float v[8];
#pragma unroll
                for (int j = 0; j < 4; ++j) { v[j] = acc[ai][0][m][0][j] * r * g0[j]; v[4 + j] = acc[ai][0][m][1][j] * r * g1[j]; }
                *(GAS u32x4*)kd = pack8(v);
#pragma unroll
                for (int j = 0; j < 4; ++j) { v[j] = acc[ai][1][m][0][j]; v[4 + j] = acc[ai][1][m][1][j]; }
                *(GAS u32x4*)(kd + 16 * MiB) = pack8(v); }
        asm volatile("s_waitcnt lgkmcnt(0)" ::: "memory"); __builtin_amdgcn_s_barrier(); asm volatile("" ::: "memory");
        return true;
    }
};
struct EpiSwiglu {
    bf16_t* H; const float* RS;
    __device__ __forceinline__ bool operator()(f32x4 (&acc)[2][2][4][2], const GUnit& u, int wr, int wc, int fr, int fq, const float (&rs)[2][4]) const {
        const int row0 = u.pm * BM + wr * 64 + fr, col0 = u.pn * HALF + wc * 32 + 8 * fq;
#pragma unroll
        for (int ai = 0; ai < 2; ++ai)
#pragma unroll
            for (int m = 0; m < 4; ++m) { float v[8]; const float r = rs[ai][m];
#pragma unroll
                for (int n = 0; n < 2; ++n)
#pragma unroll
                    for (int j = 0; j < 4; ++j) { const float g = acc[ai][0][m][n][j] * r, up = acc[ai][1][m][n][j] * r; v[4 * n + j] = g * sigmoidf_(g) * up; }
                *(GAS u32x4*)(H + (size_t)(row0 + ai * HALF + m * 16) * DFF + col0) = pack8(v); }
        return true;
    }
};
struct EpiBranch {
    const bf16_t* G; bf16_t* O;
    __device__ __forceinline__ bool operator()(f32x4 (&acc)[2][2][4][2], const GUnit& u, int wr, int wc, int fr, int fq) const {
        const int row0 = u.pm * BM + wr * 64 + fr, col0 = u.pn * BM + wc * 32 + 8 * fq; const int seg = u.seg;
        const int cn = (seg == 2 ? 2 : seg) * DM, cd = (seg == 2 ? 2 : seg + 1) * DM;
#pragma unroll
        for (int ai = 0; ai < 2; ++ai) { bf16x8 gn[4][2], gd[4][2];
#pragma unroll
            for (int m = 0; m < 4; ++m) { const size_t goff = (size_t)(row0 + ai * HALF + m * 16) * LDI + col0;
#pragma unroll
                for (int bj = 0; bj < 2; ++bj) { gn[m][bj] = *(const GAS bf16x8*)(G + goff + cn + bj * HALF); gd[m][bj] = *(const GAS bf16x8*)(G + goff + cd + bj * HALF); } }
            __builtin_amdgcn_sched_barrier(0);
#pragma unroll
            for (int m = 0; m < 4; ++m)
#pragma unroll
                for (int bj = 0; bj < 2; ++bj) { float f[8];
                    if (seg < 2) {
#pragma unroll
                        for (int j = 0; j < 8; ++j) f[j] = bf2f(gn[m][bj][j]) * fast_rcp(bf2f(gd[m][bj][j])); }
                    else {
#pragma unroll
                        for (int j = 0; j < 8; ++j) f[j] = bf2f(gn[m][bj][j]); }
#pragma unroll
                    for (int j = 0; j < 4; ++j) { acc[ai][bj][m][0][j] *= f[j]; acc[ai][bj][m][1][j] *= f[4 + j]; }
                    if (seg == 2) { float v[8];
#pragma unroll
                        for (int j = 0; j < 4; ++j) { v[j] = acc[ai][bj][m][0][j]; v[4 + j] = acc[ai][bj][m][1][j]; }
                        *(GAS u32x4*)(O + (size_t)(row0 + ai * HALF + m * 16) * DM + col0 + bj * HALF) = pack8(v); } }
            __builtin_amdgcn_sched_barrier(0); }
        return seg == 2;
    }
};

template <class Epi> struct EpiHook {
    __device__ __forceinline__ void prefetch(const Epi&, const GUnit&, int, int, LAS unsigned char*) {}
    __device__ __forceinline__ bool call(const Epi& E, f32x4 (&acc)[2][2][4][2], const GUnit& u, int wr, int wc, int fr, int fq, LAS unsigned char*) { return E(acc, u, wr, wc, fr, fq); }
};
template <class Epi> struct EpiHookRS {
    __device__ __forceinline__ void prefetch(const Epi& E, const GUnit& u, int wr, int lane, LAS unsigned char* wl) {
        if (E.RS) { const float* p = E.RS + u.pm * BM + wr * 64 + lane;
            __builtin_amdgcn_global_load_lds((const unsigned*)p, (LAS unsigned*)wl, 4, 0, 0);
            __builtin_amdgcn_global_load_lds((const unsigned*)(p + HALF), (LAS unsigned*)(wl + 256), 4, 0, 0); }
    }
    __device__ __forceinline__ bool call(const Epi& E, f32x4 (&acc)[2][2][4][2], const GUnit& u, int wr, int wc, int fr, int fq, LAS unsigned char* wl) {
        float rs[2][4];
#pragma unroll
        for (int ai = 0; ai < 2; ++ai)
#pragma unroll
            for (int m = 0; m < 4; ++m) rs[ai][m] = E.RS ? *(const LAS float*)(wl + ai * 256 + (m * 16 + fr) * 4) : 1.f;
        return E(acc, u, wr, wc, fr, fq, rs);
    }
};
template <> struct EpiHook<EpiStore> : EpiHookRS<EpiStore> {};
template <> struct EpiHook<EpiSwiglu> : EpiHookRS<EpiSwiglu> {};
template <bool F16> __device__ __forceinline__ f32x4 mma16(bf16x8 b, bf16x8 a, f32x4 c) {
    if constexpr (F16) return __builtin_amdgcn_mfma_f32_16x16x32_f16(__builtin_bit_cast(f16x8, b), __builtin_bit_cast(f16x8, a), c, 0, 0, 0);
    else return __builtin_amdgcn_mfma_f32_16x16x32_bf16(b, a, c, 0, 0, 0);
}
template <class Epi, class Sched, bool ALIGN_EPI, bool SP2, bool F16 = false>
__device__ __forceinline__ void gemm_phase(LAS unsigned char* lds, const int lda, const int ldb, const Sched& S, const Epi& E) {
    int tid = threadIdx.x; asm volatile("" : "+v"(tid));
    const int wid = __builtin_amdgcn_readfirstlane(tid >> 6), lane = tid & 63, wr = wid >> 2, wc = wid & 3, fr = lane & 15, fq = lane >> 4;
    unsigned voffA[2], voffB[2];
#pragma unroll
    for (int i = 0; i < 2; ++i) { int R, C; stage_rc(tid * 16 + i * 8192, R, C); const int Rb = (R & ~31) + perm32(R & 31);
        voffA[i] = (unsigned)(R * lda + C) * 2u; voffB[i] = (unsigned)(Rb * ldb + C) * 2u; }
    const size_t kstep = (size_t)(BK * 2);
    const size_t hstepA = (size_t)HALF * lda * 2, hstepB = (size_t)HALF * ldb * 2;
    const unsigned ldsw = (unsigned)wid * 1024u;
    const int aoff = lds_byte(wr * 64 + fr, fq * 8), boff = lds_byte(wc * 32 + fr, fq * 8);
#define PG8_SA(b, h) (((b) * 2 + (h)) * HTB)
#define PG8_SB(b, h) ((4 + (b) * 2 + (h)) * HTB)
#define PG8_STAGE(bufoff, gbase, voff) do { _Pragma("unroll") for (int _i = 0; _i < 2; ++_i) \
        __builtin_amdgcn_global_load_lds((const unsigned*)((const char*)(gbase) + (voff)[_i]), (LAS unsigned*)(lds + (bufoff) + ldsw + _i * 8192), 16, 0, 0); } while (0)
#define PG8_LDA(dst, b, h) do { _Pragma("unroll") for (int m = 0; m < 4; ++m) _Pragma("unroll") for (int k = 0; k < 2; ++k) dst[m][k] = *(const LAS bf16x8*)(lds + PG8_SA(b, h) + aoff + m * 2048 + k * 1024); } while (0)
#define PG8_LDB(dst, b, h) do { _Pragma("unroll") for (int n = 0; n < 2; ++n) _Pragma("unroll") for (int k = 0; k < 2; ++k) dst[n][k] = *(const LAS bf16x8*)(lds + PG8_SB(b, h) + boff + n * 2048 + k * 1024); } while (0)
#define PG8_MMA(ai, bj, At, Bt) do { __builtin_amdgcn_s_setprio(1); _Pragma("unroll") for (int m = 0; m < 4; ++m) _Pragma("unroll") for (int n = 0; n < 2; ++n) _Pragma("unroll") for (int k = 0; k < 2; ++k) \
        acc[ai][bj][m][n] = mma16<F16>(Bt[n][k], At[m][k], acc[ai][bj][m][n]); __builtin_amdgcn_s_setprio(0); } while (0)
#define PG8_WAIT_V(n) asm volatile("s_waitcnt vmcnt(" #n ")" ::: "memory")
#define PG8_WAIT_L(n) asm volatile("s_waitcnt lgkmcnt(" #n ")" ::: "memory")
#define PG8_BAR __builtin_amdgcn_s_barrier()
#define PG8_SCHED __builtin_amdgcn_sched_barrier(0)
    GUnit cur, nxt; int ui = 0;
    if (!S.next(0, cur)) return;
    EpiHook<Epi> HK; LAS unsigned char* const rswl = lds + RS_LDS_OFF + wid * 512; HK.prefetch(E, cur, wr, lane, rswl);
    f32x4 acc[2][2][4][2];
#pragma unroll
    for (int a = 0; a < 2; ++a)
#pragma unroll
        for (int b = 0; b < 2; ++b)
#pragma unroll
            for (int m = 0; m < 4; ++m)
#pragma unroll
                for (int n = 0; n < 2; ++n) acc[a][b][m][n] = (f32x4){0.f, 0.f, 0.f, 0.f};
    bf16x8 At[4][2], B0[2][2], B1[2][2];
    const char* cA = cur.A; const char* cB = cur.B;
    if constexpr (SP2) {
        PG8_STAGE(PG8_SB(0, 0), cB, voffB); PG8_STAGE(PG8_SB(0, 1), cB + hstepB, voffB); PG8_STAGE(PG8_SA(0, 0), cA, voffA); PG8_STAGE(PG8_SA(0, 1), cA + hstepA, voffA);
        if (wr == 1) PG8_BAR;
        PG8_WAIT_V(2); PG8_BAR;
        PG8_STAGE(PG8_SB(1, 0), cB + kstep, voffB); PG8_STAGE(PG8_SA(1, 0), cA + kstep, voffA); PG8_STAGE(PG8_SB(1, 1), cB + hstepB + kstep, voffB);
        PG8_WAIT_V(6); PG8_BAR;
    } else {
        PG8_STAGE(PG8_SB(0, 0), cB, voffB); PG8_STAGE(PG8_SA(0, 0), cA, voffA); PG8_STAGE(PG8_SB(0, 1), cB + hstepB, voffB); PG8_STAGE(PG8_SA(0, 1), cA + hstepA, voffA);
        if (wr == 1) PG8_BAR;
        PG8_WAIT_V(4); PG8_BAR;
        PG8_STAGE(PG8_SB(1, 0), cB + kstep, voffB); PG8_STAGE(PG8_SA(1, 0), cA + kstep, voffA); PG8_STAGE(PG8_SB(1, 1), cB + hstepB + kstep, voffB);
        PG8_WAIT_V(6); PG8_BAR;
    }
    for (;;) {
        const bool has_next = S.next(ui + 1, nxt);
        const char* nA = has_next ? nxt.A : cA; const char* nB = has_next ? nxt.B : cB;
        const int nt = cur.nt;
        for (int t = 0; t < nt; t += 2) {
            const bool last = (t == nt - 2);
            const char* a1 = cA + (size_t)(t + 1) * kstep;
            const char* a2 = last ? nA : cA + (size_t)(t + 2) * kstep; const char* b2 = last ? nB : cB + (size_t)(t + 2) * kstep;
            const char* a3 = a2 + kstep; const char* b3 = b2 + kstep;
            if constexpr (SP2) {
            PG8_LDB(B0, 0, 0); PG8_LDB(B1, 0, 1); PG8_SCHED; PG8_LDA(At, 0, 0); PG8_STAGE(PG8_SA(1, 1), a1 + hstepA, voffA);
            PG8_WAIT_V(8); PG8_WAIT_L(0); PG8_BAR; PG8_MMA(0, 0, At, B0); PG8_MMA(0, 1, At, B1); PG8_BAR; PG8_SCHED;
            PG8_LDA(At, 0, 1); PG8_STAGE(PG8_SB(0, 0), b2, voffB); PG8_STAGE(PG8_SB(0, 1), b2 + hstepB, voffB); PG8_STAGE(PG8_SA(0, 0), a2, voffA);
            PG8_WAIT_V(8); PG8_WAIT_L(0); PG8_BAR; PG8_MMA(1, 0, At, B0); PG8_MMA(1, 1, At, B1); PG8_BAR; PG8_SCHED;
            PG8_LDB(B0, 1, 0); PG8_LDB(B1, 1, 1); PG8_SCHED; PG8_LDA(At, 1, 0); PG8_STAGE(PG8_SA(0, 1), a2 + hstepA, voffA);
            PG8_WAIT_V(8); PG8_WAIT_L(0); PG8_BAR; PG8_MMA(0, 0, At, B0); PG8_MMA(0, 1, At, B1); PG8_BAR; PG8_SCHED;
            PG8_LDA(At, 1, 1); PG8_STAGE(PG8_SB(1, 0), b3, voffB); PG8_STAGE(PG8_SB(1, 1), b3 + hstepB, voffB); PG8_STAGE(PG8_SA(1, 0), a3, voffA);
            PG8_WAIT_V(8); PG8_WAIT_L(0); PG8_BAR; PG8_MMA(1, 0, At, B0); PG8_MMA(1, 1, At, B1); PG8_BAR; PG8_SCHED;
            } else {
            PG8_LDB(B0, 0, 0); PG8_SCHED; PG8_LDA(At, 0, 0); PG8_STAGE(PG8_SA(1, 1), a1 + hstepA, voffA);
            PG8_WAIT_L(8); PG8_BAR; PG8_WAIT_L(0); PG8_MMA(0, 0, At, B0); PG8_BAR; PG8_SCHED;
            PG8_LDB(B1, 0, 1); PG8_STAGE(PG8_SB(0, 0), b2, voffB);
            PG8_BAR; PG8_WAIT_L(0); PG8_MMA(0, 1, At, B1); PG8_BAR;
            PG8_LDA(At, 0, 1); PG8_STAGE(PG8_SA(0, 0), a2, voffA);
            PG8_BAR; PG8_WAIT_L(0); PG8_MMA(1, 0, At, B0); PG8_BAR; PG8_SCHED;
            PG8_STAGE(PG8_SB(0, 1), b2 + hstepB, voffB);
            PG8_WAIT_V(6); PG8_BAR; PG8_MMA(1, 1, At, B1); PG8_BAR;
            PG8_LDB(B0, 1, 0); PG8_SCHED; PG8_LDA(At, 1, 0); PG8_STAGE(PG8_SA(0, 1), a2 + hstepA, voffA);
            PG8_WAIT_L(8); PG8_BAR; PG8_WAIT_L(0); PG8_MMA(0, 0, At, B0); PG8_BAR; PG8_SCHED;
            PG8_LDB(B1, 1, 1); PG8_STAGE(PG8_SB(1, 0), b3, voffB);
            PG8_BAR; PG8_WAIT_L(0); PG8_MMA(0, 1, At, B1); PG8_BAR;
            PG8_LDA(At, 1, 1); PG8_STAGE(PG8_SA(1, 0), a3, voffA);
            PG8_BAR; PG8_WAIT_L(0); PG8_MMA(1, 0, At, B0); PG8_BAR; PG8_SCHED;
            PG8_STAGE(PG8_SB(1, 1), b3 + hstepB, voffB);
            PG8_WAIT_V(6); PG8_BAR; PG8_MMA(1, 1, At, B1); PG8_BAR;
            }
        }
        if constexpr (ALIGN_EPI) { if (wr == 0) PG8_BAR; }
        const bool zero = HK.call(E, acc, cur, wr, wc, fr, fq, rswl);
        if (!has_next) break;
        if (zero) {
#pragma unroll
        for (int a = 0; a < 2; ++a)
#pragma unroll
            for (int b = 0; b < 2; ++b)
#pragma unroll
                for (int m = 0; m < 4; ++m)
#pragma unroll
                    for (int n = 0; n < 2; ++n) acc[a][b][m][n] = (f32x4){0.f, 0.f, 0.f, 0.f};
        }
        cur = nxt; cA = nA; cB = nB; ++ui; HK.prefetch(E, cur, wr, lane, rswl);
        if constexpr (ALIGN_EPI) { if (wr == 1) PG8_BAR; }
    }
    PG8_WAIT_V(0);
    if constexpr (!ALIGN_EPI) { if (wr == 0) PG8_BAR; }
    PG8_BAR;
#undef PG8_SA
#undef PG8_SB
#undef PG8_STAGE
#undef PG8_LDA
#undef PG8_LDB
#undef PG8_MMA
#undef PG8_WAIT_V
#undef PG8_WAIT_L
#undef PG8_BAR
#undef PG8_SCHED
}
}

#define XB_TMO      128
#define XB_XCNT(j)  (256  + 64 * (j))
#define XB_XSUB(j)  (1280 + 64 * (j))
#define XB_XGEN(j)  (2304 + 64 * (j))
#define XB_TOP      3328
#define XB_TOPGEN   3392
#define XCD_BAR_WORDS 3456
#define XB_SPIN_CAP (1u << 18)
__device__ __forceinline__ unsigned xb_ld(unsigned* p)              { return __hip_atomic_load(p, __ATOMIC_RELAXED, __HIP_MEMORY_SCOPE_AGENT); }
__device__ __forceinline__ unsigned xb_add(unsigned* p, unsigned v) { return __hip_atomic_fetch_add(p, v, __ATOMIC_RELAXED, __HIP_MEMORY_SCOPE_AGENT); }
__device__ __forceinline__ unsigned xb_xcc_id() { return (unsigned)__builtin_amdgcn_s_getreg((3 << 11) | 20) & 0xFu; }
#define XB_SPIN(cond, bar) do { unsigned _sp = 0; while (cond) { __builtin_amdgcn_s_sleep(1); \
    if ((++_sp & 255u) == 0u) { if (xb_ld(&(bar)[XB_TMO])) break; if (_sp > XB_SPIN_CAP) { atomicAdd(&(bar)[XB_TMO], 1u); break; } } } } while (0)
struct XcdBarrier { unsigned* bar; unsigned x; volatile LAS unsigned* st; };
__device__ __forceinline__ XcdBarrier xcd_barrier_post(unsigned* bar, volatile LAS unsigned* st) {
    XcdBarrier b; b.bar = bar; b.x = xb_xcc_id(); b.st = st;
    if (threadIdx.x == 0) (void)xb_add(&bar[XB_XCNT(b.x)], 1u);
    return b;
}
__device__ __forceinline__ void xcd_barrier_complete(unsigned* bar, unsigned x, unsigned& nloc, unsigned& nx) {
    const unsigned G = gridDim.x * gridDim.y * gridDim.z;
    unsigned sum, cnt, mine, sp = 0u;
    for (;;) {
        sum = 0u; cnt = 0u; mine = 0u;
#pragma unroll
        for (unsigned j = 0; j < 16; ++j) { const unsigned c = xb_ld(&bar[XB_XCNT(j)]); sum += c; cnt += (c > 0u) ? 1u : 0u; mine = (j == x) ? c : mine; }
        if (sum == G) break;
        __builtin_amdgcn_s_sleep(1);
        if ((++sp & 255u) == 0u) { if (xb_ld(&bar[XB_TMO])) break; if (sp > XB_SPIN_CAP) { atomicAdd(&bar[XB_TMO], 1u); break; } }
    }
    nloc = mine > 0u ? mine : 1u; nx = cnt > 0u ? cnt : 1u;
}
__device__ __forceinline__ void xcd_barrier(const XcdBarrier& b) {
    asm volatile("s_waitcnt vmcnt(0)" ::: "memory");
    __syncthreads();
    if (threadIdx.x == 0) {
        unsigned* bar = b.bar;
        __builtin_amdgcn_s_waitcnt(0);
        unsigned nloc = b.st[0], nx = b.st[1];
        if (nloc == 0u) { xcd_barrier_complete(bar, b.x, nloc, nx); b.st[0] = nloc; b.st[1] = nx; }
        const unsigned old = xb_add(&bar[XB_XSUB(b.x)], 1u);
        const unsigned gen = old / nloc;
        if (old + 1u == (gen + 1u) * nloc) {
            __builtin_amdgcn_fence(__ATOMIC_RELEASE, "agent");
            asm volatile("s_waitcnt vmcnt(0)" ::: "memory");
            const unsigned og = xb_add(&bar[XB_TOP], 1u);
            const unsigned tg = og / nx;
            if (og + 1u == (tg + 1u) * nx) xb_add(&bar[XB_TOPGEN], 1u);
            else XB_SPIN(xb_ld(&bar[XB_TOPGEN]) == tg, bar);
            __builtin_amdgcn_fence(__ATOMIC_ACQUIRE, "agent");
            xb_add(&bar[XB_XGEN(b.x)], 1u);
            asm volatile("s_waitcnt vmcnt(0)" ::: "memory");
        } else {
            XB_SPIN(xb_ld(&bar[XB_XGEN(b.x)]) == gen, bar);
            __builtin_amdgcn_fence(__ATOMIC_ACQUIRE, "agent");
            asm volatile("s_waitcnt vmcnt(0)" ::: "memory");
        }
    }
    __syncthreads();
}
constexpr int CW_BAR = 4096;

struct Args { const float* in[27]; const int* pos; float* out; unsigned char* ws; int ph_lo, ph_hi; };

struct Frame {
    LAS unsigned char* lds; int tid, lane, wave, G, gw, NGW;
};

__device__ __forceinline__ int map_src_col(int maptype, int n0) {
    if (maptype == 0) return n0;
    if (maptype == 1) { if (n0 < 4096) return n0; if (n0 < 10240) return n0 + 64; if (n0 < 10304) return n0 - 6144; return -1; }
    const int pn = n0 >> 8, r = n0 & 255; return r < 128 ? 128 * pn + r : DFF + 128 * pn + (r - 128);
}
__device__ __forceinline__ void transpose_item(const float* W, int K, int Nsrc, bf16_t* WT, int nblk, const float* gain, int maptype, LAS float* scr, int item, int lane) {
    const int kb = item / nblk, nb = item % nblk, k0 = 64 * kb, n0 = 32 * nb;
    const bool f16o = (maptype & 4) != 0; maptype &= 3;
    const int sc0 = map_src_col(maptype, n0);
    float v[32];
    if (sc0 >= 0) { const GAS float* src = (const GAS float*)W + (size_t)(k0 + (lane >> 5)) * Nsrc + sc0 + (lane & 31);
#pragma unroll
        for (int i = 0; i < 32; ++i) v[i] = src[(size_t)(2 * i) * Nsrc]; }
    else {
#pragma unroll
        for (int i = 0; i < 32; ++i) v[i] = 0.f; }
#pragma unroll
    for (int i = 0; i < 32; ++i) scr[(2 * i + (lane >> 5)) * 33 + (lane & 31)] = v[i];
    LDS_WAIT(); asm volatile("" ::: "memory");
    const int c = lane & 7;
    f32x4 g0 = (f32x4){1.f, 1.f, 1.f, 1.f}, g1 = g0;
    if (gain) { g0 = *(const GAS f32x4*)(gain + k0 + 8 * c); g1 = *(const GAS f32x4*)(gain + k0 + 8 * c + 4); }
#pragma unroll
    for (int j = 0; j < 4; ++j) { const int n = (lane >> 3) + 8 * j; const LAS float* s = scr + (8 * c) * 33 + n;
        if (f16o) { f16x8 h; h[0] = (f16_t)(s[0 * 33] * g0.x); h[1] = (f16_t)(s[1 * 33] * g0.y); h[2] = (f16_t)(s[2 * 33] * g0.z); h[3] = (f16_t)(s[3 * 33] * g0.w);
            h[4] = (f16_t)(s[4 * 33] * g1.x); h[5] = (f16_t)(s[5 * 33] * g1.y); h[6] = (f16_t)(s[6 * 33] * g1.z); h[7] = (f16_t)(s[7 * 33] * g1.w);
            *(GAS f16x8*)(WT + (size_t)(n0 + n) * K + k0 + 8 * c) = h; }
        else {
        u32x4 o; o.x = cvt_pk_bf16(s[0 * 33] * g0.x, s[1 * 33] * g0.y); o.y = cvt_pk_bf16(s[2 * 33] * g0.z, s[3 * 33] * g0.w); o.z = cvt_pk_bf16(s[4 * 33] * g1.x, s[5 * 33] * g1.y); o.w = cvt_pk_bf16(s[6 * 33] * g1.z, s[7 * 33] * g1.w);
        *(GAS u32x4*)(WT + (size_t)(n0 + n) * K + k0 + 8 * c) = o; } }
    LDS_WAIT(); asm volatile("" ::: "memory");
}
struct ConvJob { const float* W; int K, Nsrc; bf16_t* WT; int Nd; const float* gain; int maptype; };
__device__ __forceinline__ int conv_items(const ConvJob& j) { return (j.K / 64) * (j.Nd / 32); }

template <int U> __device__ __forceinline__ void rms_rows(const float* x, bf16_t* o, int r0, int lane) {
    f32x4 v[U][8];
#pragma unroll
    for (int u = 0; u < U; ++u) { const GAS f32x4* xr = (const GAS f32x4*)(x + (size_t)(r0 + u) * DM) + lane;
#pragma unroll
        for (int j = 0; j < 8; ++j) v[u][j] = xr[64 * j]; }
#pragma unroll
    for (int u = 0; u < U; ++u) { float s = 0.f;
#pragma unroll
        for (int j = 0; j < 8; ++j) s += (v[u][j].x * v[u][j].x + v[u][j].y * v[u][j].y) + (v[u][j].z * v[u][j].z + v[u][j].w * v[u][j].w);
        const float r = 1.0f / sqrtf(wave_sum(s) * (1.f / 2048.f) + EPS);
        GAS u32x2* op = (GAS u32x2*)(o + (size_t)(r0 + u) * DM) + lane;
#pragma unroll
        for (int j = 0; j < 8; ++j) { u32x2 w; w.x = cvt_pk_bf16(v[u][j].x * r, v[u][j].y * r); w.y = cvt_pk_bf16(v[u][j].z * r, v[u][j].w * r); op[64 * j] = w; } }
}
template <int U> __device__ __forceinline__ void cvt_rows(const float* x, f16_t* o16, float* RS, int r0, int lane) {
    f32x4 v[U][8];
#pragma unroll
    for (int u = 0; u < U; ++u) { const GAS f32x4* xr = (const GAS f32x4*)(x + (size_t)(r0 + u) * DM) + lane;
#pragma unroll
        for (int j = 0; j < 8; ++j) v[u][j] = xr[64 * j]; }
#pragma unroll
    for (int u = 0; u < U; ++u) { float s = 0.f;
#pragma unroll
        for (int j = 0; j < 8; ++j) s += (v[u][j].x * v[u][j].x + v[u][j].y * v[u][j].y) + (v[u][j].z * v[u][j].z + v[u][j].w * v[u][j].w);
        s = wave_sum(s);
        if (lane == 0) ((GAS float*)RS)[r0 + u] = 1.0f / sqrtf(s * (1.f / 2048.f) + EPS);
        typedef _Float16 f16x4 __attribute__((ext_vector_type(4))); GAS f16x4* hp = (GAS f16x4*)(o16 + (size_t)(r0 + u) * DM) + lane;
#pragma unroll
        for (int j = 0; j < 8; ++j) { f16x4 h; h[0] = (f16_t)v[u][j].x; h[1] = (f16_t)v[u][j].y; h[2] = (f16_t)v[u][j].z; h[3] = (f16_t)v[u][j].w; hp[64 * j] = h; } }
}
__device__ __forceinline__ void reduce_ss(const float* SS, float* RS, int idx, int nthr) {
    for (int i = idx; i < M * 4; i += nthr) { const int row = i >> 2, q = i & 3; const GAS f32x4* p = (const GAS f32x4*)(SS + (size_t)row * 32 + q * 8); const f32x4 a = p[0], b = p[1];
        float s = (a[0] + a[1]) + (a[2] + a[3]) + (b[0] + b[1]) + (b[2] + b[3]); s += __shfl_xor(s, 1); s += __shfl_xor(s, 2);
        if (q == 0) ((GAS float*)RS)[row] = 1.0f / sqrtf(s * (1.f / 2048.f) + EPS); }
}
template <int GL> __device__ __forceinline__ float group_sum(float v) {
#pragma unroll
    for (int o = 1; o < GL; o <<= 1) v += __shfl_xor(v, o);
    return v;
}
struct G8 { float g[8]; };
__device__ __forceinline__ G8 ld_gain8(const float* p) { G8 r; const f32x4 a = *(const GAS f32x4*)p, b = *(const GAS f32x4*)(p + 4); r.g[0] = a[0]; r.g[1] = a[1]; r.g[2] = a[2]; r.g[3] = a[3]; r.g[4] = b[0]; r.g[5] = b[1]; r.g[6] = b[2]; r.g[7] = b[3]; return r; }
__device__ __forceinline__ G8 ones8() { G8 r;
#pragma unroll
    for (int j = 0; j < 8; ++j) r.g[j] = 1.f; return r; }
template <int GL> __device__ __forceinline__ u32x4 norm8(bf16x8 x, const G8& gn, float scale) {
    float f[8], s = 0.f;
#pragma unroll
    for (int j = 0; j < 8; ++j) { f[j] = bf2f(x[j]); s += f[j] * f[j]; }
    s = group_sum<GL>(s); const float r = scale / sqrtf(s * (1.f / (8 * GL)) + EPS);
#pragma unroll
    for (int j = 0; j < 8; ++j) f[j] = f[j] * r * gn.g[j];
    return pack8(f);
}
__device__ __forceinline__ u32x4 scale8(bf16x8 x, float scale) { float f[8];
#pragma unroll
    for (int j = 0; j < 8; ++j) f[j] = bf2f(x[j]) * scale;
    return pack8(f); }
__device__ __forceinline__ u32x4 norm_rope8(bf16x8 x, bf16x8 x2, const G8& gn, float scale, const f32x4* cs  , int c) {
    float f[8], s = 0.f;
#pragma unroll
    for (int j = 0; j < 8; ++j) { f[j] = bf2f(x[j]) + bf2f(x2[j]); s += f[j] * f[j]; }
    s = group_sum<8>(s); const float r = 1.0f / sqrtf(s * (1.f / 64.f) + EPS);
    float o[8];
#pragma unroll
    for (int j = 0; j < 8; ++j) f[j] = f[j] * r * gn.g[j];
#pragma unroll
    for (int j = 0; j < 8; ++j) { const float xp = __shfl_xor(f[j], 4); const float cv = cs[j >> 1][2 * (j & 1)], sv = cs[j >> 1][2 * (j & 1) + 1];
        o[j] = ((c < 4) ? (f[j] * cv - xp * sv) : (xp * sv + f[j] * cv)) * scale; }
    return pack8(o);
}

namespace att {
#define KSWZ(row, colB) ((row) * 256 + ((colB) ^ (((row) & 7) << 4)))
#define K2SWZ(row, colB) ((row) * 128 + ((colB) ^ ((((row) >> 1) & 7) << 4)))
#define SBAR() __builtin_amdgcn_sched_barrier(0)
constexpr int A_V = 0, A_K = 32768, A_K2 = 65536;
constexpr int A_WS = LDSCTL_OFF + 2048, A_TAB = LDSCTL_OFF + 4096;
__device__ __forceinline__ int v_st(int k, int c) { const int kk = (k & ~0xC) | ((k & 4) << 1) | ((k & 8) >> 1); return ((kk >> 3) * 4 + (c >> 5)) * 512 + ((kk & 7) * 32 + (c & 31)) * 2; }
__device__ __forceinline__ int v_rd_base(int lane) { return ((lane & 3) << 3) | (((lane >> 2) & 3) << 6) | (((lane >> 4) & 1) << 5) | (((lane >> 5) & 1) << 8); }
constexpr int v_rd_off(int d0, int ks, int half) { return d0 * 512 + ks * 4096 + half * 2048; }
template <int OFF> __device__ __forceinline__ s16x4 tr_read(int vb) {
    s16x4 r; asm volatile("ds_read_b64_tr_b16 %0, %1 offset:%2" : "=&v"(r) : "v"(vb), "i"(OFF) : "memory"); return r;
}
template <int D0> __device__ __forceinline__ void pv_one(f32x16& od, int vb, bf16x8 pa0, bf16x8 pa1, bf16x8 pa2, bf16x8 pa3) {
    const s16x4 l0 = tr_read<v_rd_off(D0, 0, 0)>(vb), h0 = tr_read<v_rd_off(D0, 0, 1)>(vb), l1 = tr_read<v_rd_off(D0, 1, 0)>(vb), h1 = tr_read<v_rd_off(D0, 1, 1)>(vb);
    const s16x4 l2 = tr_read<v_rd_off(D0, 2, 0)>(vb), h2 = tr_read<v_rd_off(D0, 2, 1)>(vb), l3 = tr_read<v_rd_off(D0, 3, 0)>(vb), h3 = tr_read<v_rd_off(D0, 3, 1)>(vb);
    asm volatile("s_waitcnt lgkmcnt(0)" ::: "memory"); SBAR();
#define PK(L, H) (bf16x8){L[0], L[1], L[2], L[3], H[0], H[1], H[2], H[3]}
    od = __builtin_amdgcn_mfma_f32_32x32x16_bf16(pa0, PK(l0, h0), od, 0, 0, 0);
    od = __builtin_amdgcn_mfma_f32_32x32x16_bf16(pa1, PK(l1, h1), od, 0, 0, 0);
    od = __builtin_amdgcn_mfma_f32_32x32x16_bf16(pa2, PK(l2, h2), od, 0, 0, 0);
    od = __builtin_amdgcn_mfma_f32_32x32x16_bf16(pa3, PK(l3, h3), od, 0, 0, 0);
#undef PK
}
__device__ __forceinline__ float xhalf_max(float v) { auto rr = __builtin_amdgcn_permlane32_swap(__float_as_uint(v), __float_as_uint(v), false, false); return fmaxf(__uint_as_float(rr[0]), __uint_as_float(rr[1])); }
__device__ __forceinline__ float xhalf_sum(float v) { auto rr = __builtin_amdgcn_permlane32_swap(__float_as_uint(v), __float_as_uint(v), false, false); return __uint_as_float(rr[0]) + __uint_as_float(rr[1]); }
constexpr int crow0(int r) { return (r & 3) + 8 * (r >> 2); }

template <int KOFF> __device__ __forceinline__ float sb_half_prod(f32x16& p, const float base, const int dq4, const int hi) {
    float keep[16];
#pragma unroll
    for (int r = 0; r < 16; ++r) { const float e = fast_exp2(fminf(-p[r] * LOG2E, 100.f)), b = fast_rcp(1.f + e); const bool v = KOFF + crow0(r) < dq4; keep[r] = v ? e * b : 1.f; p[r] = v ? b : 0.f; }
    float gh1[4], gh0[4];
#pragma unroll
    for (int g = 0; g < 4; ++g) { const float own = (keep[4 * g] * keep[4 * g + 1]) * (keep[4 * g + 2] * keep[4 * g + 3]);
        auto rr = __builtin_amdgcn_permlane32_swap(__float_as_uint(own), __float_as_uint(own), false, false);
        const float other = __uint_as_float(hi ? rr[0] : rr[1]); gh1[g] = hi ? own : other; gh0[g] = hi ? other : own; }
    float R = base;
#pragma unroll
    for (int g = 3; g >= 0; --g) { float w = hi ? R : R * gh1[g];
        const float b3 = p[4 * g + 3], b2 = p[4 * g + 2], b1 = p[4 * g + 1], b0 = p[4 * g];
        p[4 * g + 3] = b3 * w; w *= keep[4 * g + 3]; p[4 * g + 2] = b2 * w; w *= keep[4 * g + 2]; p[4 * g + 1] = b1 * w; w *= keep[4 * g + 1]; p[4 * g] = b0 * w;
        R = R * (gh1[g] * gh0[g]); }
    return R;
}

template <int MODE>
__device__ __forceinline__ void attn_unit(LAS unsigned char* lds, const bf16_t* Qb, int ldq, const bf16_t* Kb, int ldk, const bf16_t* K2b, const bf16_t* Vb, int ldv, bf16_t* Ob, int ldo,
                                          int q0, float sink2, const float* qgain, const f32x4* rope_rows  ) {
    int tid = threadIdx.x; asm volatile("" : "+v"(tid));
    const int wid = __builtin_amdgcn_readfirstlane(tid >> 6), lane = tid & 63, r32 = lane & 31, hi = lane >> 5;
    constexpr int ND = (MODE == 2) ? 12 : 8;
    bf16x8 qr[ND];
    { const bf16_t* Qw = Qb + (size_t)(wid * 32 + r32) * ldq + hi * 8;
#pragma unroll
      for (int d0 = 0; d0 < ND; ++d0) qr[d0] = *(const GAS bf16x8*)(Qw + d0 * 16);
      constexpr float QSC = (MODE == 1) ? 0.08838834764831845f : (MODE == 2 ? 0.07216878364870323f * LOG2E : 0.08838834764831845f * LOG2E);
      f32x4 gq[8][2], gr[2][4], rcs[2][4];
      if (MODE != 1) {
#pragma unroll
          for (int d0 = 0; d0 < 8; ++d0) { gq[d0][0] = *(const GAS f32x4*)(qgain + d0 * 16 + hi * 8); gq[d0][1] = *(const GAS f32x4*)(qgain + d0 * 16 + hi * 8 + 4); } }
      if (MODE == 2) { const GAS f32x4* rp = (const GAS f32x4*)rope_rows + (size_t)(wid * 32 + r32) * 16;
#pragma unroll
          for (int dd = 0; dd < 2; ++dd) { gr[dd][0] = *(const GAS f32x4*)(qgain + 128 + dd * 16 + hi * 8); gr[dd][1] = *(const GAS f32x4*)(qgain + 128 + dd * 16 + hi * 8 + 4);
              gr[dd][2] = *(const GAS f32x4*)(qgain + 160 + dd * 16 + hi * 8); gr[dd][3] = *(const GAS f32x4*)(qgain + 160 + dd * 16 + hi * 8 + 4);
#pragma unroll
              for (int q = 0; q < 4; ++q) rcs[dd][q] = rp[8 * dd + 4 * hi + q]; } }
      __builtin_amdgcn_sched_barrier(0);
      float rn = QSC, rr = QSC;
      if (MODE != 1) { float s = 0.f;
#pragma unroll
          for (int d0 = 0; d0 < 8; ++d0)
#pragma unroll
              for (int j = 0; j < 8; ++j) { const float f = bf2f(qr[d0][j]); s += f * f; }
          s = xhalf_sum(s); rn = QSC / sqrtf(s * (1.f / 128.f) + EPS);
          if (MODE == 2) { float s2 = 0.f;
#pragma unroll
              for (int d0 = 8; d0 < ND; ++d0)
#pragma unroll
                  for (int j = 0; j < 8; ++j) { const float f = bf2f(qr[d0][j]); s2 += f * f; }
              s2 = xhalf_sum(s2); rr = QSC / sqrtf(s2 * (1.f / 64.f) + EPS); } }
#pragma unroll
      for (int d0 = 0; d0 < 8; ++d0) { float f[8];
          if (MODE != 1) { const f32x4 g0 = gq[d0][0], g1 = gq[d0][1];
#pragma unroll
              for (int j = 0; j < 4; ++j) { f[j] = bf2f(qr[d0][j]) * rn * g0[j]; f[4 + j] = bf2f(qr[d0][4 + j]) * rn * g1[j]; } }
          else {
#pragma unroll
              for (int j = 0; j < 8; ++j) f[j] = bf2f(qr[d0][j]) * rn; }
          qr[d0] = __builtin_bit_cast(bf16x8, pack8(f)); }
      if (MODE == 2) {
#pragma unroll
          for (int dd = 0; dd < 2; ++dd) { float x1[8], x2[8], o1[8], o2[8];
              const f32x4 ga = gr[dd][0], gb = gr[dd][1], gc = gr[dd][2], gd = gr[dd][3];
#pragma unroll
              for (int j = 0; j < 4; ++j) { x1[j] = bf2f(qr[(MODE == 2 ? 8 : 0) + dd][j]) * rr * ga[j]; x1[4 + j] = bf2f(qr[(MODE == 2 ? 8 : 0) + dd][4 + j]) * rr * gb[j];
                  x2[j] = bf2f(qr[(MODE == 2 ? 10 : 0) + dd][j]) * rr * gc[j]; x2[4 + j] = bf2f(qr[(MODE == 2 ? 10 : 0) + dd][4 + j]) * rr * gd[j]; }
#pragma unroll
              for (int j = 0; j < 8; ++j) { const f32x4 cs = rcs[dd][j >> 1]; const float cv = cs[2 * (j & 1)], sv = cs[2 * (j & 1) + 1];
                  o1[j] = x1[j] * cv - x2[j] * sv; o2[j] = x1[j] * sv + x2[j] * cv; }
              qr[(MODE == 2 ? 8 : 0) + dd] = __builtin_bit_cast(bf16x8, pack8(o1)); qr[(MODE == 2 ? 10 : 0) + dd] = __builtin_bit_cast(bf16x8, pack8(o2)); }
      }
    }
    const int qw = q0 + wid * 32;
    int jt0, jt1;
    if (MODE == 0) { jt0 = (q0 >> 6) - 2; jt0 = jt0 < 0 ? 0 : jt0; jt1 = (q0 >> 6) + 3; }
    else if (MODE == 3) { jt0 = 0; jt1 = 3; }
    else { jt0 = 0; jt1 = (q0 >> 6) + 3; }
    const int NT = jt1 - jt0 + 1;
    const int sr = tid >> 4, sc = (tid & 15) * 8, vst0 = v_st(sr, sc), vst1 = v_st(32 + sr, sc), kst0 = KSWZ(sr, sc * 2), kst1 = KSWZ(32 + sr, sc * 2);
    const int s2r = tid >> 3, s2c = (tid & 7) * 8, k2st = K2SWZ(s2r, s2c * 2);
    bf16x8 sk0, sk1, sv0, sv1, sk2;
#define SLOAD(kt) do { const size_t kr0 = (size_t)((kt) * 64 + sr); sk0 = *(const GAS bf16x8*)(Kb + kr0 * ldk + sc); sk1 = *(const GAS bf16x8*)(Kb + (kr0 + 32) * ldk + sc); \
        sv0 = *(const GAS bf16x8*)(Vb + kr0 * ldv + sc); sv1 = *(const GAS bf16x8*)(Vb + (kr0 + 32) * ldv + sc); \
        if (MODE == 2) sk2 = *(const GAS bf16x8*)(K2b + (size_t)((kt) * 64 + s2r) * 64 + s2c); } while (0)
#define SWRITE(b) do { *(LAS bf16x8*)(lds + A_V + (b) * 16384 + vst0) = sv0; *(LAS bf16x8*)(lds + A_V + (b) * 16384 + vst1) = sv1; \
        *(LAS bf16x8*)(lds + A_K + (b) * 16384 + kst0) = sk0; *(LAS bf16x8*)(lds + A_K + (b) * 16384 + kst1) = sk1; \
        if (MODE == 2) *(LAS bf16x8*)(lds + A_K2 + (b) * 8192 + k2st) = sk2; } while (0)
#define TILE(j) (MODE == 1 ? jt1 - (j) : jt0 + (j))
    const int vb0 = (int)(unsigned)(uintptr_t)(lds + A_V) + v_rd_base(lane);
    LAS float* wsf = (LAS float*)(lds + A_WS) + wid * 64;
    const LAS float* tab = (const LAS float*)(lds + A_TAB);
    f32x16 o[4];
#pragma unroll
    for (int d = 0; d < 4; ++d)
#pragma unroll
        for (int r = 0; r < 16; ++r) o[d][r] = 0.f;
    float m_reg = (MODE == 0) ? sink2 : -1e30f, l_reg = (MODE == 0) ? 1.f : 0.f, carry = 1.f;

    bf16x8 tk0, tk1, tv0, tv1, tk2;
#define SLOADB(kt) do { const size_t kr0 = (size_t)((kt) * 64 + sr); tk0 = *(const GAS bf16x8*)(Kb + kr0 * ldk + sc); tk1 = *(const GAS bf16x8*)(Kb + (kr0 + 32) * ldk + sc); \
        tv0 = *(const GAS bf16x8*)(Vb + kr0 * ldv + sc); tv1 = *(const GAS bf16x8*)(Vb + (kr0 + 32) * ldv + sc); \
        if (MODE == 2) tk2 = *(const GAS bf16x8*)(K2b + (size_t)((kt) * 64 + s2r) * 64 + s2c); } while (0)
#define SWRITEB(b) do { *(LAS bf16x8*)(lds + A_V + (b) * 16384 + vst0) = tv0; *(LAS bf16x8*)(lds + A_V + (b) * 16384 + vst1) = tv1; \
        *(LAS bf16x8*)(lds + A_K + (b) * 16384 + kst0) = tk0; *(LAS bf16x8*)(lds + A_K + (b) * 16384 + kst1) = tk1; \
        if (MODE == 2) *(LAS bf16x8*)(lds + A_K2 + (b) * 8192 + k2st) = tk2; } while (0)
    auto compute = [&](const int j, const int buf) __attribute__((always_inline)) {
        const int kt = TILE(j), k0 = kt * 64;
        bool need;
        if (MODE == 0) need = (k0 + 63 >= qw - 127) && (k0 <= qw + 31);
        else if (MODE == 3) need = true;
        else need = (k0 <= qw + 31);
        if (need) {
            f32x16 p0, p1;
#pragma unroll
            for (int r = 0; r < 16; ++r) { p0[r] = 0.f; p1[r] = 0.f; }
            { const LAS unsigned char* Kt = lds + A_K + buf * 16384;
#pragma unroll
              for (int d0 = 0; d0 < 8; ++d0) { const int cb = (d0 * 16 + hi * 8) * 2;
                  const bf16x8 a0 = *(const LAS bf16x8*)(Kt + KSWZ(r32, cb)), a1 = *(const LAS bf16x8*)(Kt + KSWZ(32 + r32, cb));
                  p0 = __builtin_amdgcn_mfma_f32_32x32x16_bf16(a0, qr[d0], p0, 0, 0, 0); p1 = __builtin_amdgcn_mfma_f32_32x32x16_bf16(a1, qr[d0], p1, 0, 0, 0); }
              if (MODE == 2) { const LAS unsigned char* K2t = lds + A_K2 + buf * 8192;
#pragma unroll
                  for (int d2 = 0; d2 < 4; ++d2) { const int cb = (d2 * 16 + hi * 8) * 2;
                      const bf16x8 a0 = *(const LAS bf16x8*)(K2t + K2SWZ(r32, cb)), a1 = *(const LAS bf16x8*)(K2t + K2SWZ(32 + r32, cb));
                      p0 = __builtin_amdgcn_mfma_f32_32x32x16_bf16(a0, qr[(MODE == 2 ? 8 : 0) + d2], p0, 0, 0, 0); p1 = __builtin_amdgcn_mfma_f32_32x32x16_bf16(a1, qr[(MODE == 2 ? 8 : 0) + d2], p1, 0, 0, 0); } } }
            const int dq4 = qw + r32 - k0 - 4 * hi;
            if (MODE == 1) {
                carry = sb_half_prod<32>(p1, carry, dq4, hi);
                carry = sb_half_prod<0>(p0, carry, dq4, hi);
            } else {
                if (MODE == 0) {
#pragma unroll
                    for (int r = 0; r < 16; ++r) { p0[r] += tab[dq4 + 96 - crow0(r)]; p1[r] += tab[dq4 + 96 - 32 - crow0(r)]; }
                }
                if (MODE == 2) { if (k0 + 63 > qw) {
#pragma unroll
                    for (int r = 0; r < 16; ++r) { if (crow0(r) > dq4) p0[r] = -1e30f; if (32 + crow0(r) > dq4) p1[r] = -1e30f; } } }
                float pmax = p0[0];
#pragma unroll
                for (int r = 1; r < 16; ++r) pmax = fmaxf(pmax, p0[r]);
#pragma unroll
                for (int r = 0; r < 16; ++r) pmax = fmaxf(pmax, p1[r]);
                pmax = xhalf_max(pmax);
                const float mn = fmaxf(m_reg, pmax), alpha = fast_exp2(m_reg - mn); m_reg = mn;
                float ps = 0.f;
#pragma unroll
                for (int r = 0; r < 16; ++r) { p0[r] = fast_exp2(p0[r] - mn); p1[r] = fast_exp2(p1[r] - mn); ps += p0[r] + p1[r]; }
                ps = xhalf_sum(ps);
                l_reg = l_reg * alpha + ps;
                if (__any(alpha < 1.f)) { if (hi == 0) wsf[r32] = alpha; asm volatile("s_waitcnt lgkmcnt(0)" ::: "memory");
#pragma unroll
                    for (int r = 0; r < 16; ++r) { const float a = wsf[crow0(r) + 4 * hi];
#pragma unroll
                        for (int d = 0; d < 4; ++d) o[d][r] *= a; }
                    asm volatile("s_waitcnt lgkmcnt(0)" ::: "memory"); }
            }
            bf16x8 pa0, pa1, pa2, pa3;
#define PK4(P, BASE, OUT) do { unsigned a0 = cvt_pk_bf16(P[BASE + 0], P[BASE + 1]), a1 = cvt_pk_bf16(P[BASE + 2], P[BASE + 3]); \
    unsigned b0 = cvt_pk_bf16(P[BASE + 4], P[BASE + 5]), b1 = cvt_pk_bf16(P[BASE + 6], P[BASE + 7]); \
    auto r0 = __builtin_amdgcn_permlane32_swap(a0, b0, false, false); auto r1 = __builtin_amdgcn_permlane32_swap(a1, b1, false, false); \
    u32x4 w = {r0[0], r1[0], r0[1], r1[1]}; OUT = __builtin_bit_cast(bf16x8, w); } while (0)
            PK4(p0, 0, pa0); PK4(p0, 8, pa1); PK4(p1, 0, pa2); PK4(p1, 8, pa3);
#undef PK4
            const int vb = vb0 + buf * 16384;
            pv_one<0>(o[0], vb, pa0, pa1, pa2, pa3); pv_one<1>(o[1], vb, pa0, pa1, pa2, pa3); pv_one<2>(o[2], vb, pa0, pa1, pa2, pa3); pv_one<3>(o[3], vb, pa0, pa1, pa2, pa3);
        }
    };
    SLOAD(TILE(0)); SWRITE(0); __syncthreads();
    if (NT > 1) SLOAD(TILE(1));
    if (NT > 2) SLOADB(TILE(2));
    for (int j = 0; j < NT; j += 2) {
        compute(j, 0);
        if (j + 1 < NT) { SWRITE(1); if (j + 3 < NT) SLOAD(TILE(j + 3)); }
        __syncthreads();
        if (j + 1 < NT) {
            compute(j + 1, 1);
            if (j + 2 < NT) { SWRITEB(0); if (j + 4 < NT) SLOADB(TILE(j + 4)); }
            __syncthreads();
        }
    }
    LAS float* ot = (LAS float*)(lds + wid * 16384);
#pragma unroll
    for (int d = 0; d < 4; ++d)
#pragma unroll
        for (int r = 0; r < 16; ++r) ot[(crow0(r) + 4 * hi) * 128 + d * 32 + r32] = o[d][r];
    if (MODE != 1) { if (hi == 0) wsf[r32] = l_reg; }
    asm volatile("s_waitcnt lgkmcnt(0)" ::: "memory");
#pragma unroll
    for (int i = 0; i < 8; ++i) { const int row = i * 4 + (lane >> 4), c8 = lane & 15;
        const f32x4 a = *(const LAS f32x4*)(ot + row * 128 + c8 * 8), b = *(const LAS f32x4*)(ot + row * 128 + c8 * 8 + 4);
        const float rl = (MODE != 1) ? 1.f / wsf[row] : 1.f;
        float v[8] = {a[0] * rl, a[1] * rl, a[2] * rl, a[3] * rl, b[0] * rl, b[1] * rl, b[2] * rl, b[3] * rl};
        *(GAS u32x4*)(Ob + (size_t)(wid * 32 + row) * ldo + c8 * 8) = pack8(v); }
    __syncthreads();
#undef SLOAD
#undef SWRITE
#undef SLOADB
#undef SWRITEB
#undef TILE
}

__device__ __forceinline__ void swa_band_unit(LAS unsigned char* lds, const bf16_t* Qg, int ldq, const bf16_t* Kh, const bf16_t* Vh, bf16_t* Og, int ldo, int q0, int h0,
                                              const float* sinks, const float* qgain, const LAS float* tabs) {
    int tid = threadIdx.x; asm volatile("" : "+v"(tid));
    const int wid = __builtin_amdgcn_readfirstlane(tid >> 6), lane = tid & 63, r32 = lane & 31, hi = lane >> 5;
    const int t0 = (q0 >> 6) - 2;
    { const int sr = tid >> 4, sc = (tid & 15) * 8, vst0 = v_st(sr, sc), vst1 = v_st(32 + sr, sc), kst0 = KSWZ(sr, sc * 2), kst1 = KSWZ(32 + sr, sc * 2);
      bf16x8 sk[4][2], sv[4][2];
#pragma unroll
      for (int tt = 0; tt < 4; ++tt) { const int kt = t0 + tt; if (kt >= 0) { const size_t kr0 = (size_t)(kt * 64 + sr);
          sk[tt][0] = *(const GAS bf16x8*)(Kh + kr0 * 128 + sc); sk[tt][1] = *(const GAS bf16x8*)(Kh + (kr0 + 32) * 128 + sc);
          sv[tt][0] = *(const GAS bf16x8*)(Vh + kr0 * 128 + sc); sv[tt][1] = *(const GAS bf16x8*)(Vh + (kr0 + 32) * 128 + sc); } }
#pragma unroll
      for (int tt = 0; tt < 4; ++tt) { const int kt = t0 + tt; if (kt >= 0) {
          *(LAS bf16x8*)(lds + tt * 16384 + kst0) = sk[tt][0]; *(LAS bf16x8*)(lds + tt * 16384 + kst1) = sk[tt][1];
          *(LAS bf16x8*)(lds + 65536 + tt * 16384 + vst0) = sv[tt][0]; *(LAS bf16x8*)(lds + 65536 + tt * 16384 + vst1) = sv[tt][1]; } }
    }
    __syncthreads();
    const int vb0 = (int)(unsigned)(uintptr_t)(lds + 65536) + v_rd_base(lane);
    LAS float* wsf = (LAS float*)(lds + A_WS) + wid * 64;
    for (int pass = 0; pass < 2; ++pass) {
        const int task = wid + 8 * pass, g = task >> 2, rbk = task & 3, qw = q0 + rbk * 32;
        bf16x8 qr[8];
        { const bf16_t* Qw = Qg + (size_t)(rbk * 32 + r32) * ldq + g * 128 + hi * 8;
#pragma unroll
          for (int d0 = 0; d0 < 8; ++d0) qr[d0] = *(const GAS bf16x8*)(Qw + d0 * 16);
          f32x4 gq[8][2];
#pragma unroll
          for (int d0 = 0; d0 < 8; ++d0) { gq[d0][0] = *(const GAS f32x4*)(qgain + d0 * 16 + hi * 8); gq[d0][1] = *(const GAS f32x4*)(qgain + d0 * 16 + hi * 8 + 4); }
          __builtin_amdgcn_sched_barrier(0);
          float s = 0.f;
#pragma unroll
          for (int d0 = 0; d0 < 8; ++d0)
#pragma unroll
              for (int j = 0; j < 8; ++j) { const float f = bf2f(qr[d0][j]); s += f * f; }
          s = xhalf_sum(s); const float rn = (0.08838834764831845f * LOG2E) / sqrtf(s * (1.f / 128.f) + EPS);
#pragma unroll
          for (int d0 = 0; d0 < 8; ++d0) { float f[8];
#pragma unroll
              for (int j = 0; j < 4; ++j) { f[j] = bf2f(qr[d0][j]) * rn * gq[d0][0][j]; f[4 + j] = bf2f(qr[d0][4 + j]) * rn * gq[d0][1][j]; }
              qr[d0] = __builtin_bit_cast(bf16x8, pack8(f)); } }
        f32x16 o[4];
#pragma unroll
        for (int d = 0; d < 4; ++d)
#pragma unroll
            for (int r = 0; r < 16; ++r) o[d][r] = 0.f;
        float m_reg = ((const GAS float*)sinks)[h0 + g] * LOG2E, l_reg = 1.f;
        const LAS float* tab = tabs + (h0 + g) * 320;
        for (int tt = 0; tt < 4; ++tt) { const int kt = t0 + tt, k0 = kt * 64;
            if (kt < 0 || k0 + 63 < qw - 127 || k0 > qw + 31) continue;
            f32x16 p0, p1;
#pragma unroll
            for (int r = 0; r < 16; ++r) { p0[r] = 0.f; p1[r] = 0.f; }
            { const LAS unsigned char* Kt = lds + tt * 16384;
#pragma unroll
              for (int d0 = 0; d0 < 8; ++d0) { const int cb = (d0 * 16 + hi * 8) * 2;
                  const bf16x8 a0 = *(const LAS bf16x8*)(Kt + KSWZ(r32, cb)), a1 = *(const LAS bf16x8*)(Kt + KSWZ(32 + r32, cb));
                  p0 = __builtin_amdgcn_mfma_f32_32x32x16_bf16(a0, qr[d0], p0, 0, 0, 0); p1 = __builtin_amdgcn_mfma_f32_32x32x16_bf16(a1, qr[d0], p1, 0, 0, 0); } }
            const int dq4 = qw + r32 - k0 - 4 * hi;
#pragma unroll
            for (int r = 0; r < 16; ++r) { p0[r] += tab[dq4 + 96 - crow0(r)]; p1[r] += tab[dq4 + 96 - 32 - crow0(r)]; }
            float pmax = p0[0];
#pragma unroll
            for (int r = 1; r < 16; ++r) pmax = fmaxf(pmax, p0[r]);
#pragma unroll
            for (int r = 0; r < 16; ++r) pmax = fmaxf(pmax, p1[r]);
            pmax = xhalf_max(pmax);
            const float mn = fmaxf(m_reg, pmax), alpha = fast_exp2(m_reg - mn); m_reg = mn;
            float ps = 0.f;
#pragma unroll
            for (int r = 0; r < 16; ++r) { p0[r] = fast_exp2(p0[r] - mn); p1[r] = fast_exp2(p1[r] - mn); ps += p0[r] + p1[r]; }
            ps = xhalf_sum(ps);
            l_reg = l_reg * alpha + ps;
            if (__any(alpha < 1.f)) { if (hi == 0) wsf[r32] = alpha; asm volatile("s_waitcnt lgkmcnt(0)" ::: "memory");
#pragma unroll
                for (int r = 0; r < 16; ++r) { const float a = wsf[crow0(r) + 4 * hi];
#pragma unroll
                    for (int d = 0; d < 4; ++d) o[d][r] *= a; }
                asm volatile("s_waitcnt lgkmcnt(0)" ::: "memory"); }
            bf16x8 pa0, pa1, pa2, pa3;
#define PK4(P, BASE, OUT) do { unsigned a0 = cvt_pk_bf16(P[BASE + 0], P[BASE + 1]), a1 = cvt_pk_bf16(P[BASE + 2], P[BASE + 3]); \
    unsigned b0 = cvt_pk_bf16(P[BASE + 4], P[BASE + 5]), b1 = cvt_pk_bf16(P[BASE + 6], P[BASE + 7]); \
    auto r0 = __builtin_amdgcn_permlane32_swap(a0, b0, false, false); auto r1 = __builtin_amdgcn_permlane32_swap(a1, b1, false, false); \
    u32x4 w = {r0[0], r1[0], r0[1], r1[1]}; OUT = __builtin_bit_cast(bf16x8, w); } while (0)
            PK4(p0, 0, pa0); PK4(p0, 8, pa1); PK4(p1, 0, pa2); PK4(p1, 8, pa3);
#undef PK4
            const int vb = vb0 + tt * 16384;
            pv_one<0>(o[0], vb, pa0, pa1, pa2, pa3); pv_one<1>(o[1], vb, pa0, pa1, pa2, pa3); pv_one<2>(o[2], vb, pa0, pa1, pa2, pa3); pv_one<3>(o[3], vb, pa0, pa1, pa2, pa3);
        }
        if (hi == 0) wsf[r32] = l_reg; asm volatile("s_waitcnt lgkmcnt(0)" ::: "memory");
#pragma unroll
        for (int r = 0; r < 16; ++r) { const int row = crow0(r) + 4 * hi; const float rl = 1.f / wsf[row];
            GAS unsigned short* op = (GAS unsigned short*)(Og + (size_t)(rbk * 32 + row) * ldo + g * 128 + r32);
#pragma unroll
            for (int d = 0; d < 4; ++d) op[d * 32] = (unsigned short)(cvt_pk_bf16(o[d][r] * rl, 0.f) & 0xffffu); }
        asm volatile("s_waitcnt lgkmcnt(0)" ::: "memory");
    }
    __syncthreads();
}
#undef KSWZ
#undef K2SWZ
#undef SBAR
}

struct SchedXkv { pg8::TileOrder T; const char* A; const char* B;
    __device__ bool next(int i, pg8::GUnit& u) const { const long L = (long)i * T.G + T.c; if (L >= 256) return false; const int l = (int)L >> 6, r = (int)L & 63, pm = r >> 2, pn = r & 3;
        u.A = A + (size_t)pm * 256 * DM * 2; u.B = B + (size_t)l * 4 * MiB + (size_t)pn * 256 * DM * 2; u.nt = 32; u.pm = l * 16 + pm; u.pn = pn; u.seg = 0; return true; } };
__device__ __forceinline__ unsigned long long pt_ld(LAS unsigned char* lds, int k) {
    asm volatile("" ::: "memory");
    const unsigned long long v = ((const LAS unsigned long long*)(lds + PT_OFF))[k];
    const unsigned lo = __builtin_amdgcn_readfirstlane((unsigned)v), hi = __builtin_amdgcn_readfirstlane((unsigned)(v >> 32));
    return ((unsigned long long)hi << 32) | lo;
}
#define INP(k) ((const float*)pt_ld(F.lds, (k)))
#define WSP() ((unsigned char*)pt_ld(F.lds, 28))
#define OUTP() ((float*)pt_ld(F.lds, 27))
__global__ void __launch_bounds__(NWAVES * 64, 2) trunk_fwd(Args args) {
    extern __shared__ __attribute__((aligned(16))) unsigned char lds_raw[];
    Frame F;
    F.lds = (LAS unsigned char*)lds_raw;
    volatile LAS unsigned* MISC = (volatile LAS unsigned*)(F.lds + MISC_OFF);
    F.tid = threadIdx.x; F.lane = F.tid & 63; F.wave = __builtin_amdgcn_readfirstlane(F.tid >> 6);
    F.G = gridDim.x; const int bx = blockIdx.x; const int vcu = (F.G % 8 == 0) ? (bx % 8) * (F.G / 8) + bx / 8 : bx;
    F.gw = vcu * NWAVES + F.wave; F.NGW = F.G * NWAVES;
    for (int u = F.tid; u < (LDS_BYTES - LDSCTL_OFF) / 4; u += NWAVES * 64) ((LAS unsigned*)(F.lds + LDSCTL_OFF))[u] = 0u;
    __syncthreads();
    if (F.tid == 0) { LAS unsigned long long* PT = (LAS unsigned long long*)(F.lds + PT_OFF);
#pragma unroll
        for (int k = 0; k < 27; ++k) PT[k] = (unsigned long long)args.in[k];
        PT[27] = (unsigned long long)args.out; PT[28] = (unsigned long long)args.ws; }
    __syncthreads();
    const int lo = args.ph_lo, hi = args.ph_hi;
    const bool use_bar = (hi - lo) > 1;
    XcdBarrier bar; bar.bar = (unsigned*)(WSP() + WS_CTL) + CW_BAR; bar.x = 0; bar.st = nullptr;
    if (use_bar) bar = xcd_barrier_post((unsigned*)(WSP() + WS_CTL) + CW_BAR, MISC + 8);
#define IN(k) (lo <= (k) && (k) < hi)
#define SEAM(k) do { if (IN(k) && IN((k) + 1)) xcd_barrier(bar); } while (0)
#define WSB(off) ((bf16_t*)(ws + (off)))
    LAS float* scr = (LAS float*)(F.lds + F.wave * 16384);

#define PHASE_PROLOG(lv) int LN = threadIdx.x & 63; asm volatile("" : "+v"(LN)); int LQ = (lv); asm volatile("" : "+s"(LQ)); int BX = blockIdx.x; asm volatile("" : "+s"(BX)); \
    int GG = gridDim.x; asm volatile("" : "+s"(GG)); const int VC = (GG % 8 == 0) ? (BX % 8) * (GG / 8) + BX / 8 : BX, GW = VC * NWAVES + F.wave, NGW = GG * NWAVES; (void)LN; (void)LQ; (void)GW; (void)NGW; (void)VC;
    if (PHON(18) && IN(0)) { PHASE_PROLOG(0)
        unsigned char* ws = WSP();
        for (int l = 0; l < DEPTH; ++l) {
            const int nit = (2048 / 64) * (1024 / 32);
            for (int it = GW; it < nit; it += NGW)
                transpose_item(INP(20) + (size_t)l * 2048 * 1024, 2048, 1024, WSB(WS_WXKV + (size_t)l * 4 * MiB), 1024 / 32, INP(18) + l * 2048, 0, scr, it, LN);
        }
        const float* mem = INP(1);
        for (int r0 = GW * 2; r0 < MMEM; r0 += NGW * 2) rms_rows<2>(mem, WSB(WS_MEMN), r0, LN);
        { const GAS int* positions = (const GAS int*)INP(2); GAS f32x2* ROPE = (GAS f32x2*)(ws + WS_ROPE);
          for (int idx = GW * 64 + LN; idx < M * 32; idx += NGW * 64) { const int row = idx >> 5, i = idx & 31;
              const float inv = exp2f(-(float)i * (13.287712379549449f / 32.f)); float sn, cs; sincosf((float)positions[row] * inv, &sn, &cs); ROPE[idx] = (f32x2){cs, sn}; } }
    }
    SEAM(0);
    if (PHON(19) && IN(1)) { PHASE_PROLOG(0)
        unsigned char* ws = WSP();
        SchedXkv S; S.T.G = GG; S.T.c = BX; S.A = (const char*)WSB(WS_MEMN); S.B = (const char*)(ws + WS_WXKV);
        pg8::EpiStore E{WSB(WS_XKV), 1024, 0, 0, nullptr, 3};
        pg8::gemm_phase<pg8::EpiStore, SchedXkv, true, true>(F.lds, DM, DM, S, E);
    }
    SEAM(1);
    if (PHON(20) && IN(2)) { PHASE_PROLOG(0)
        unsigned char* ws = WSP(); const float* g = INP(22);
        for (int r = GW; r < DEPTH * MMEM; r += NGW) { const int l = r / MMEM; const int h = LN >> 4, c = LN & 15; const int bb = (r >> 8) & 15, ss = r & 255;
            bf16_t* p = WSB(WS_XKV) + ((size_t)(((l * 16 + bb) * 4 + h) * 2 + 0) * 256 + ss) * 128 + c * 8; const G8 gn = ld_gain8(g + l * 128 + c * 8); *(GAS u32x4*)p = norm8<16>(*(const GAS bf16x8*)p, gn, 1.f); }
    }
    SEAM(2);

    for (int l = 0; l < DEPTH; ++l) {
        const int P = NPRE + l * NP;
        if (PHON(0) && IN(P + 0)) { PHASE_PROLOG(l)
            unsigned char* ws = WSP(); unsigned char* WL = ws + WS_WL;
#define CJ(wi, K_, Ns_, off_, Nd_, gi, mt) { const int n = ((K_) / 64) * ((Nd_) / 32); if (r >= 0 && r < n) { const float* gn = (gi) >= 0 ? INP((gi) < 0 ? 0 : (gi)) + (size_t)LQ * (K_) : nullptr; \
                transpose_item(INP(wi) + (size_t)LQ * (K_) * (Ns_), (K_), (Ns_), (bf16_t*)(WL + (off_)), (Nd_) / 32, gn, (mt), scr, r, LN); } r -= n; }
            constexpr int TOTAL = (2048 / 64) * (LDI / 32) + (2048 / 64) * (2 * DFF / 32) + (DFF / 64) * (2048 / 32) + 2 * (2048 / 64) * (2048 / 32) + (2048 / 64) * (512 / 32) + (512 / 64) * (2048 / 32) + (512 / 64) * (1024 / 32) + (512 / 64) * (768 / 32);
            for (int it = GW; it < TOTAL; it += NGW) { int r = it;
                CJ(5, 2048, IN_W, WL_IN, LDI, 4, 1 | 4)
                CJ(25, 2048, 2 * DFF, WL_GU, 2 * DFF, 24, 2 | 4)
                CJ(26, DFF, 2048, WL_DN, 2048, -1, 0)
                CJ(15, 2048, 2048, WL_BR, 2048, -1, 0)
                CJ(16, 2048, 2048, WL_OUT, 2048, -1, 0)
                CJ(19, 2048, 512, WL_XQ, 512, 17, 0 | 4)
                CJ(23, 512, 2048, WL_XO, 2048, -1, 0)
                CJ(12, 512, 1024, WL_UKV, 1024, 10, 0)
                CJ(11, 512, 768, WL_UQ, 768, 9, 0)
            }
#undef CJ
            if (LQ == 0) { const float* xcur = INP(0); for (int r0 = GW * 4; r0 < M; r0 += NGW * 4) cvt_rows<4>(xcur, (f16_t*)(ws + WS_X16), (float*)(ws + WS_RS), r0, LN); }
            else reduce_ss((const float*)(ws + WS_SS), (float*)(ws + WS_RS), GW * 64 + LN, NGW * 64);
        }
        SEAM(P + 0);
        if (PHON(1) && IN(P + 1)) { PHASE_PROLOG(l)
            unsigned char* ws = WSP();
            pg8::SchedIn S; S.init(WSB(WS_X16), WSB(WS_WL + WL_IN), GG, BX);
            pg8::EpiStore E{WSB(WS_IN), LDI, C_G / 256, C_KR / 256, nullptr, 1, (const float*)(ws + WS_RS)};
            pg8::gemm_phase<pg8::EpiStore, pg8::SchedIn, true, true, true>(F.lds, DM, DM, S, E);
        }
        SEAM(P + 1);
        if (PHON(2) && IN(P + 2)) { PHASE_PROLOG(l)
            unsigned char* ws = WSP(); bf16_t* INb = WSB(WS_IN); bf16_t* KR = WSB(WS_KR); const bf16_t* KR2 = WSB(WS_KR2); bf16_t* KAc = WSB(WS_KA);
            const float* gk = INP(7) + LQ * 128; const float* kg = INP(14) + LQ * 192;
            const int c16 = LN & 15, h4 = LN >> 4; const GAS f32x4* ROPE = (const GAS f32x4*)(ws + WS_ROPE);
            const G8 gk8 = ld_gain8(gk + c16 * 8), gr8 = ld_gain8(kg + 128 + (LN & 7) * 8), one = ones8();
            constexpr int U = 4;
            for (int r0 = GW * U; r0 < M; r0 += NGW * U) {
                bf16x8 kav[U], cqv[U], ckvv[U], krv[U], kr2[U]; f32x4 cs[U][4];
#pragma unroll
                for (int u = 0; u < U; ++u) { const bf16_t* row = INb + (size_t)(r0 + u) * LDI;
                    kav[u] = *(const GAS bf16x8*)(KAc + ((size_t)(((r0 + u) >> 11) * 2 + (h4 & 1)) * SEQ + ((r0 + u) & (SEQ - 1))) * 128 + c16 * 8);
                    cqv[u] = *(const GAS bf16x8*)(row + C_CQ + LN * 8); ckvv[u] = *(const GAS bf16x8*)(row + C_CKV + LN * 8); krv[u] = *(const GAS bf16x8*)(row + C_KR + (LN & 7) * 8); kr2[u] = *(const GAS bf16x8*)(KR2 + (size_t)(r0 + u) * 256 + (LN & 7) * 8);
#pragma unroll
                    for (int q = 0; q < 4; ++q) cs[u][q] = ROPE[(size_t)(r0 + u) * 16 + (LN & 3) * 4 + q]; }
#pragma unroll
                for (int u = 0; u < U; ++u) { bf16_t* row = INb + (size_t)(r0 + u) * LDI;
                    { const u32x4 w = norm8<16>(kav[u], gk8, 1.f); if (LN < 32) *(GAS u32x4*)(KAc + ((size_t)(((r0 + u) >> 11) * 2 + h4) * SEQ + ((r0 + u) & (SEQ - 1))) * 128 + c16 * 8) = w; }
                    *(GAS u32x4*)(row + C_CQ + LN * 8) = norm8<64>(cqv[u], one, 1.f);
                    *(GAS u32x4*)(row + C_CKV + LN * 8) = norm8<64>(ckvv[u], one, 1.f);
                    { const u32x4 w = norm_rope8(krv[u], kr2[u], gr8, 1.f, cs[u], LN & 7); if (LN < 8) *(GAS u32x4*)(KR + (size_t)(r0 + u) * 64 + LN * 8) = w; } }
            }
        }
        SEAM(P + 2);
        if (PHON(3) && IN(P + 3)) { PHASE_PROLOG(l)
            { unsigned char* ws = WSP(); pg8::SchedSimple S; S.init(WSB(WS_IN) + C_CQ, LDI, WSB(WS_WL + WL_UQ), 512, M, 768, 512, GG, GG - 1 - BX);
              pg8::EpiStore E{WSB(WS_QC), 768, 0, 0, nullptr};
              pg8::gemm_phase<pg8::EpiStore, pg8::SchedSimple, true, true>(F.lds, LDI, 512, S, E); }
            { unsigned char* ws = WSP(); pg8::SchedSimple S; S.init(WSB(WS_IN) + C_CKV, LDI, WSB(WS_WL + WL_UKV), 512, M, 1024, 512, GG, BX);
              pg8::EpiUkv E{WSB(WS_KVC), INP(14) + LQ * 192, (LAS float*)(F.lds + LDSCTL_OFF + 6144)};
              pg8::gemm_phase<pg8::EpiUkv, pg8::SchedSimple, true, true>(F.lds, LDI, 512, S, E); }
        }
        SEAM(P + 3);
        if (PHON(5) && IN(P + 5)) { PHASE_PROLOG(l)
            for (int u = VC; u < BATCH * 16; u += GG) { const int pr = u & 3, h = (u >> 2) & 3, b = u >> 4; const size_t rb = (size_t)b * SEQ;
                for (int ps = 0; ps < 2; ++ps) { const int q0 = (ps == 0 ? 7 - pr : pr) * 256; unsigned char* ws = WSP();
                    att::attn_unit<1>(F.lds, WSB(WS_IN) + (rb + q0) * LDI + C_QB + h * 128, LDI, WSB(WS_KB) + (size_t)(b * 4 + h) * SEQ * 128, 128, nullptr, WSB(WS_VB) + (size_t)(b * 4 + h) * SEQ * 128, 128,
                                      WSB(WS_XN) + (rb + q0) * DM + 1024 + h * 128, DM, q0, 0.f, nullptr, nullptr); } }
            { { int tid = threadIdx.x; asm volatile("" : "+v"(tid));
                const GAS float* rel_bias = (const GAS float*)INP(3);
                if (tid < 320) { const int rel = tid - 96; int bk = 0; const bool inw = rel >= 0 && rel < 128;
                    if (inw) { if (rel < 16) bk = rel; else { bk = 16 + (int)(logf((float)rel / 16.f) / logf(8.f) * 16.f); bk = bk > 31 ? 31 : bk; } }
#pragma unroll
                    for (int hh = 0; hh < 8; ++hh) ((LAS float*)(F.lds + att::A_TAB))[hh * 320 + tid] = inw ? rel_bias[bk * 8 + hh] * LOG2E : -1e30f; }
                __syncthreads(); }
              for (int u = VC; u < BATCH * 32; u += GG) { const int blk = u & 15, kvh = (u >> 4) & 1, b = u >> 5, q0 = blk * 128; const size_t rb = (size_t)b * SEQ; unsigned char* ws = WSP();
                att::swa_band_unit(F.lds, WSB(WS_IN) + (rb + q0) * LDI + C_QA + kvh * 512, LDI, WSB(WS_KA) + (size_t)(b * 2 + kvh) * SEQ * 128, WSB(WS_VA) + (size_t)(b * 2 + kvh) * SEQ * 128,
                                   WSB(WS_XN) + (rb + q0) * DM + kvh * 512, DM, q0, kvh * 4, INP(8) + LQ * 8, INP(6) + LQ * 128, (const LAS float*)(F.lds + att::A_TAB)); } }
            for (int u = VC; u < BATCH * 16; u += GG) { const int pr = u & 3, h = (u >> 2) & 3, b = u >> 4; const size_t rb = (size_t)b * SEQ;
                for (int ps = 0; ps < 2; ++ps) { const int q0 = (ps == 0 ? 7 - pr : pr) * 256;
                    unsigned char* ws = WSP(); const bf16_t* QC = WSB(WS_QC); const bf16_t* KVC = WSB(WS_KVC); const bf16_t* KR = WSB(WS_KR); bf16_t* OCAT = WSB(WS_XN); const float* qg = INP(13) + LQ * 192; const GAS f32x4* ROPE = (const GAS f32x4*)(ws + WS_ROPE);
                    att::attn_unit<2>(F.lds, QC + (rb + q0) * 768 + h * 192, 768, KVC + (size_t)(b * 4 + h) * SEQ * 128, 128, KR + rb * 64, KVC + 16 * MiB + (size_t)(b * 4 + h) * SEQ * 128, 128,
                                      OCAT + (rb + q0) * DM + 1536 + h * 128, DM, q0, 0.f, qg, (const f32x4*)(ROPE + (rb + q0) * 16)); } }
        }
        SEAM(P + 5);
        if (PHON(6) && IN(P + 6)) { PHASE_PROLOG(l)
            unsigned char* ws = WSP();
            pg8::SchedBranch S; S.init(WSB(WS_XN), WSB(WS_WL + WL_BR), GG, BX);
            pg8::EpiBranch E{WSB(WS_IN) + C_G, (bf16_t*)OUTP()};
            pg8::gemm_phase<pg8::EpiBranch, pg8::SchedBranch, true, true>(F.lds, DM, DM, S, E);
        }
        SEAM(P + 6);
        if (PHON(7) && IN(P + 7)) { PHASE_PROLOG(l)
            unsigned char* ws = WSP();
            pg8::SchedSimple S; S.init((const bf16_t*)OUTP(), DM, WSB(WS_WL + WL_OUT), DM, M, DM, DM, GG, BX);
            pg8::EpiResX E{(f16_t*)(ws + WS_X16), (float*)(ws + WS_SS)};
            pg8::gemm_phase<pg8::EpiResX, pg8::SchedSimple, false, true>(F.lds, DM, DM, S, E);
        }
        SEAM(P + 7);
        if (PHON(9) && IN(P + 9)) { PHASE_PROLOG(l)
            unsigned char* ws = WSP();
            pg8::SchedSimple S; S.init(WSB(WS_X16), DM, WSB(WS_WL + WL_XQ), DM, M, 512, DM, GG, BX);
            pg8::EpiStore E{WSB(WS_XQ), 512, 0, 0, (const float*)(ws + WS_SS)};
            pg8::gemm_phase<pg8::EpiStore, pg8::SchedSimple, true, true, true>(F.lds, DM, DM, S, E);
        }
        SEAM(P + 9);
        if (PHON(10) && IN(P + 10)) { PHASE_PROLOG(l)
            unsigned char* ws = WSP(); const bf16_t* XQ = WSB(WS_XQ); bf16_t* XO = WSB(WS_XO); const float* g = INP(21) + LQ * 128;
            const bf16_t* XKVl = WSB(WS_XKV) + (size_t)LQ * MMEM * 1024;
            for (int u = VC; u < BATCH * 32; u += GG) { const int i = u & 7, h = (u >> 3) & 3, b = u >> 5, q0 = i * 256; const size_t rb = (size_t)b * SEQ;
                const bf16_t* Kb = XKVl + (size_t)((b * 4 + h) * 2) * 256 * 128;
                att::attn_unit<3>(F.lds, XQ + (rb + q0) * 512 + h * 128, 512, Kb, 128, nullptr, Kb + 256 * 128, 128, XO + (rb + q0) * 512 + h * 128, 512, q0, 0.f, g, nullptr); }
        }
        SEAM(P + 10);
        if (PHON(11) && IN(P + 11)) { PHASE_PROLOG(l)
            unsigned char* ws = WSP();
            pg8::SchedSimple S; S.init(WSB(WS_XO), 512, WSB(WS_WL + WL_XO), 512, M, DM, 512, GG, BX);
            pg8::EpiResX E{(f16_t*)(ws + WS_X16), (float*)(ws + WS_SS)};
            pg8::gemm_phase<pg8::EpiResX, pg8::SchedSimple, false, true>(F.lds, 512, 512, S, E);
        }
        SEAM(P + 11);
        if (PHON(12) && IN(P + 12)) { PHASE_PROLOG(l) unsigned char* ws = WSP(); reduce_ss((const float*)(ws + WS_SS), (float*)(ws + WS_RS), GW * 64 + LN, NGW * 64); }
        SEAM(P + 12);
        if (PHON(13) && IN(P + 13)) { PHASE_PROLOG(l)
            unsigned char* ws = WSP();
            pg8::SchedSimple S; S.init(WSB(WS_X16), DM, WSB(WS_WL + WL_GU), DM, M, 2 * DFF, DM, GG, BX);
            pg8::EpiSwiglu E{WSB(WS_IN), (const float*)(ws + WS_RS)};
            pg8::gemm_phase<pg8::EpiSwiglu, pg8::SchedSimple, true, true, true>(F.lds, DM, DM, S, E);
        }
        SEAM(P + 13);
        if (PHON(14) && IN(P + 14)) { PHASE_PROLOG(l)
            unsigned char* ws = WSP();
            pg8::SchedSimple S; S.init(WSB(WS_IN), DFF, WSB(WS_WL + WL_DN), DFF, M, DM, DFF, GG, BX);
            if (LQ == DEPTH - 1) { pg8::EpiResF E{(const f16_t*)(ws + WS_X16), OUTP()}; pg8::gemm_phase<pg8::EpiResF, pg8::SchedSimple, false, true>(F.lds, DFF, DFF, S, E); }
            else { pg8::EpiResX E{(f16_t*)(ws + WS_X16), (float*)(ws + WS_SS)}; pg8::gemm_phase<pg8::EpiResX, pg8::SchedSimple, false, true>(F.lds, DFF, DFF, S, E); }
        }
        SEAM(P + 14);
    }
#undef IN
#undef SEAM
#undef WSB
}

extern "C" void kernel_launch(void* const* d_in, const int* in_sizes, int n_in, void* d_out, int out_size, void* d_ws, size_t ws_size, hipStream_t stream) {
    static int grid = 0;
    if (grid == 0) {
        if (n_in != 27 || out_size != M * DM || ws_size < WS_END) { fprintf(stderr, "kernel_launch: unexpected shapes: n_in %d out %d ws %zu (need %zu)\n", n_in, out_size, ws_size, (size_t)WS_END); grid = -1; return; }
        int dev = 0, cus = 0;
        if (hipGetDevice(&dev) != hipSuccess || hipDeviceGetAttribute(&cus, hipDeviceAttributeMultiprocessorCount, dev) != hipSuccess) { grid = -1; return; }
        if (hipFuncSetAttribute((const void*)trunk_fwd, hipFuncAttributeMaxDynamicSharedMemorySize, LDS_BYTES) != hipSuccess) { fprintf(stderr, "kernel_launch: hipFuncSetAttribute failed\n"); grid = -1; return; }
        int per_cu = 0;
        if (hipOccupancyMaxActiveBlocksPerMultiprocessor(&per_cu, (const void*)trunk_fwd, NWAVES * 64, LDS_BYTES) != hipSuccess || per_cu < 1) fprintf(stderr, "kernel_launch: occupancy query says %d\n", per_cu);
        (void)hipGetLastError();
        grid = cus;
    }
    if (grid < 0) return;
    (void)hipMemsetAsync((char*)d_ws + WS_CTL, 0, CTL_ZERO_BYTES, stream);
    Args a{};
    for (int i = 0; i < 27; ++i) a.in[i] = (const float*)d_in[i];
    a.pos = (const int*)d_in[2]; a.out = (float*)d_out; a.ws = (unsigned char*)d_ws;
#if MK_ONE_LAUNCH
    a.ph_lo = 0; a.ph_hi = NPHASE;
    hipLaunchKernelGGL(trunk_fwd, dim3(grid), dim3(NWAVES * 64), LDS_BYTES, stream, a);
#else
    for (int p = 0; p < NPHASE; ++p) { a.ph_lo = p; a.ph_hi = p + 1; hipLaunchKernelGGL(trunk_fwd, dim3(grid), dim3(NWAVES * 64), LDS_BYTES, stream, a); }
#endif
    if (PROBE_SET) {
        for (int l = 0; l < DEPTH; ++l) for (int k = 0; k < NP; ++k) if ((PROBE_SET >> k) & 1ull) {
            Args b = a; b.ph_lo = NPRE + l * NP + k; b.ph_hi = b.ph_lo + 1;
            if (k == 7) b.out = (float*)((unsigned char*)d_ws + WS_IN); if (k == 11 || k == 14 || k == 8 || k == 12) b.out = (float*)((unsigned char*)d_ws + WS_XN);
            hipLaunchKernelGGL(trunk_fwd, dim3(grid), dim3(NWAVES * 64), LDS_BYTES, stream, b); }
    }
    const hipError_t le = hipPeekAtLastError();
    if (le != hipSuccess) fprintf(stderr, "kernel_launch: launch failed: %s\n", hipGetErrorName(le));
}
```

```cpp
#include <hip/hip_runtime.h>
#include <cstdio>
#include <cstdint>

#ifndef PHASE_MASK
#define PHASE_MASK 0xFFFFFFFFull
#endif
#define PHON(k) (((PHASE_MASK) >> (k)) & 1ull)
#ifndef ATT_MFMA
#define ATT_MFMA 0xF
#endif
#ifndef PROBE_SET
#define PROBE_SET 0ull
#endif
#ifndef MK_ONE_LAUNCH
#define MK_ONE_LAUNCH 1
#endif

#define GAS __attribute__((address_space(1)))
#define LAS __attribute__((address_space(3)))
typedef unsigned short bf16_t;
typedef short bf16x8 __attribute__((ext_vector_type(8)));
typedef _Float16 f16_t;
typedef _Float16 f16x8 __attribute__((ext_vector_type(8)));
typedef short s16x4 __attribute__((ext_vector_type(4)));
typedef float f32x2 __attribute__((ext_vector_type(2)));
typedef float f32x4 __attribute__((ext_vector_type(4)));
typedef float f32x16 __attribute__((ext_vector_type(16)));
typedef unsigned u32x2 __attribute__((ext_vector_type(2)));
typedef unsigned u32x4 __attribute__((ext_vector_type(4)));
typedef GAS unsigned gu32;

constexpr int BATCH = 16, SEQ = 2048, DM = 2048, M = BATCH * SEQ, DEPTH = 4;
constexpr int MEMLEN = 256, MMEM = BATCH * MEMLEN;
constexpr int IN_W = 10304, LDI = 10496;
constexpr int DFF = 5632;
constexpr float EPS = 1e-6f;
constexpr float LOG2E = 1.4426950408889634f;
constexpr int C_QA = 0, C_KA = 1024, C_VA = 1280, C_QB = 1536, C_KB = 2048, C_VB = 2560, C_CQ = 3072, C_CKV = 3584, C_G = 4096, C_KR = 10240;
constexpr int NP = 15;
constexpr int NPRE = 3;
constexpr int NPHASE = NPRE + DEPTH * NP;

constexpr size_t MiB = 1u << 20;
constexpr size_t WS_CTL = 0, CTL_ZERO_BYTES = 1 * MiB;
constexpr size_t WS_TAB = 1 * MiB;
constexpr size_t WS_WL = 2 * MiB;
constexpr size_t WL_IN = 0, WL_GU = 41 * MiB, WL_DN = 85 * MiB, WL_BR = 107 * MiB, WL_OUT = 115 * MiB, WL_XQ = 123 * MiB, WL_XO = 125 * MiB, WL_UKV = 127 * MiB, WL_UQ = 128 * MiB;
constexpr size_t WS_WXKV = 132 * MiB;
constexpr size_t WS_IN = 148 * MiB;
constexpr size_t WS_XN = 804 * MiB;
constexpr size_t WS_X16 = 932 * MiB;
constexpr size_t WS_QC = 1060 * MiB;
constexpr size_t WS_KVC = 1108 * MiB;
constexpr size_t WS_KR = 1172 * MiB;
constexpr size_t WS_MEMN = 1176 * MiB;
constexpr size_t WS_XKV = 1192 * MiB;
constexpr size_t WS_XQ = WS_IN + 416 * MiB;
constexpr size_t WS_KA = 1224 * MiB, WS_VA = 1240 * MiB;
constexpr size_t WS_XO = 1256 * MiB;
constexpr size_t WS_ROPE = 1288 * MiB;
constexpr size_t WS_SS = 1296 * MiB;
constexpr size_t WS_KR2 = 1300 * MiB;
constexpr size_t WS_KB = 1316 * MiB, WS_VB = 1348 * MiB;
constexpr size_t WS_RS = 1380 * MiB;
constexpr size_t WS_END = 1381 * MiB;
static_assert(WS_IN + (size_t)M * LDI * 2 <= WS_XN && WL_UQ + 768 * 512 * 2 <= 130 * MiB, "ws map");

constexpr int RING_BYTES = 131072;
constexpr int LDSCTL_OFF = RING_BYTES, MISC_OFF = LDSCTL_OFF + 320, PT_OFF = LDSCTL_OFF + 1024;
constexpr int RS_LDS_OFF = LDSCTL_OFF + 10240;
constexpr int LDS_BYTES = 147456;
constexpr int NWAVES = 8;

#define RLX_AGENT __ATOMIC_RELAXED, __HIP_MEMORY_SCOPE_AGENT
#define LDS_WAIT() asm volatile("s_waitcnt lgkmcnt(0)" ::: "memory")
#define VM_WAIT() asm volatile("s_waitcnt vmcnt(0)" ::: "memory")
__device__ __forceinline__ unsigned cvt_pk_bf16(float lo, float hi) { unsigned r; asm volatile("v_cvt_pk_bf16_f32 %0, %1, %2" : "=v"(r) : "v"(lo), "v"(hi)); return r; }
__device__ __forceinline__ float bf2f(short h) { return __builtin_bit_cast(float, ((unsigned)(unsigned short)h) << 16); }
__device__ __forceinline__ float wave_sum(float v) {
#pragma unroll
    for (int o = 1; o < 64; o <<= 1) v += __shfl_xor(v, o);
    return v;
}
__device__ __forceinline__ float wave_max(float v) {
#pragma unroll
    for (int o = 1; o < 64; o <<= 1) v = fmaxf(v, __shfl_xor(v, o));
    return v;
}
__device__ __forceinline__ float fast_exp2(float x) { return __builtin_amdgcn_exp2f(x); }
__device__ __forceinline__ float fast_rcp(float x) { return __builtin_amdgcn_rcpf(x); }
__device__ __forceinline__ float sigmoidf_(float z) { return fast_rcp(1.f + fast_exp2(-z * LOG2E)); }
__device__ __forceinline__ u32x4 pack8(const float* v) { u32x4 w; w.x = cvt_pk_bf16(v[0], v[1]); w.y = cvt_pk_bf16(v[2], v[3]); w.z = cvt_pk_bf16(v[4], v[5]); w.w = cvt_pk_bf16(v[6], v[7]); return w; }

namespace pg8 {
constexpr int BM = 256, BK = 64, HALF = 128, HTB = HALF * BK * 2, NXCD = 8, WGM = 4;
__host__ __device__ __forceinline__ int lds_byte(int r, int c) { const int st = (r >> 4) * 2 + (c >> 5), rr = r & 15, cc = c & 31, ob = rr * 64 + cc * 2; return st * 1024 + (ob ^ (((ob >> 9) & 1) << 5)); }
__host__ __device__ __forceinline__ void stage_rc(int b, int& R, int& C) { const int st = b / 1024, sb = b % 1024, swz = sb ^ (((sb >> 9) & 1) << 5); R = (st >> 1) * 16 + swz / 64; C = (st & 1) * 32 + (swz % 64) / 2; }
__host__ __device__ __forceinline__ int perm32(int rho) { const int n = rho >> 4, i = rho & 15; return 8 * (i >> 2) + 4 * n + (i & 3); }

struct GUnit { const char* A; const char* B; int nt; int pm, pn, seg; };

struct TileOrder {
    int nM, nN, nwg, G, c;
    __device__ void init(int nM_, int nN_, int G_, int c_) { nM = nM_; nN = nN_; nwg = nM * nN; G = G_; c = c_; }
    __device__ bool tile(int i, int& pm, int& pn) const {
        const long L = (long)i * G + c; if (L >= nwg) return false;
        int wgid = (int)L; { const int q = nwg / NXCD, r = nwg % NXCD, xcd = wgid % NXCD, off = wgid / NXCD; wgid = (xcd < r ? xcd * (q + 1) : r * (q + 1) + (xcd - r) * q) + off; }
        const int nig = WGM * nN, gid = wgid / nig, fm = gid * WGM, gsz = (nM - fm) < WGM ? (nM - fm) : WGM;
        pm = fm + ((wgid % nig) % gsz); pn = (wgid % nig) / gsz; return true;
    }
};
struct SchedSimple {
    TileOrder T; const char* A; const char* B; size_t tA, tB; int nt;
    __device__ void init(const bf16_t* A_, int lda, const bf16_t* B_, int ldb, int Mr, int N, int K, int G, int c) { T.init(Mr / BM, N / BM, G, c); A = (const char*)A_; B = (const char*)B_; tA = (size_t)BM * lda * 2; tB = (size_t)BM * ldb * 2; nt = K / BK; }
    __device__ bool next(int i, GUnit& u) const { int pm, pn; if (!T.tile(i, pm, pn)) return false; u.A = A + pm * tA; u.B = B + pn * tB; u.nt = nt; u.pm = pm; u.pn = pn; u.seg = 0; return true; }
};
struct SchedIn {
    TileOrder T; const char* A; const char* B; size_t tA, tB;
    __device__ void init(const bf16_t* A_, const bf16_t* B_, int G, int c) { T.init(M / BM, 40, G, c); A = (const char*)A_; B = (const char*)B_; tA = (size_t)BM * DM * 2; tB = (size_t)BM * DM * 2; }
    __device__ bool next(int i, GUnit& u) const { int pm, pn;
        if (T.tile(i, pm, pn)) { u.A = A + pm * tA; u.B = B + pn * tB; u.nt = 32; u.pm = pm; u.pn = pn; u.seg = 0; return true; }
        const long hu = (long)i * T.G + T.c - T.nwg; if (hu < 0 || hu >= 256) return false;
        const int kh = (int)hu & 1; pm = (int)hu >> 1; u.A = A + pm * tA + kh * 2048; u.B = B + 40 * tB + kh * 2048; u.nt = 16; u.pm = pm; u.pn = 40 + kh; u.seg = 0; return true; }
};
struct SchedBranch {
    TileOrder T; const char* A; const char* B; size_t tA, tB;
    __device__ void init(const bf16_t* A_, const bf16_t* B_, int G, int c) { T.init(M / BM, DM / BM, G, c); A = (const char*)A_; B = (const char*)B_; tA = (size_t)BM * DM * 2; tB = (size_t)BM * DM * 2; }
    __device__ bool next(int i, GUnit& u) const { int pm, pn; const int ti = i / 3, seg = i - 3 * ti; if (!T.tile(ti, pm, pn)) return false;
        const int koff = seg == 0 ? 0 : (seg == 1 ? 1024 : 1536); u.A = A + pm * tA + koff * 2; u.B = B + pn * tB + koff * 2; u.nt = seg == 0 ? 16 : 8; u.pm = pm; u.pn = pn; u.seg = seg; return true; }
};

__device__ __forceinline__ void row_scales(const float* SS, int row0, int fq, float (&rs)[2][4]) {
    f32x4 pa_[2][4], pb_[2][4];
#pragma unroll
    for (int ai = 0; ai < 2; ++ai)
#pragma unroll
        for (int m = 0; m < 4; ++m) { const float* p = SS + (size_t)(row0 + ai * HALF + m * 16) * 32 + fq * 8; pa_[ai][m] = *(const GAS f32x4*)p; pb_[ai][m] = *(const GAS f32x4*)(p + 4); }
    __builtin_amdgcn_sched_barrier(0);
#pragma unroll
    for (int ai = 0; ai < 2; ++ai)
#pragma unroll
        for (int m = 0; m < 4; ++m) { const f32x4 a = pa_[ai][m], b = pb_[ai][m];
            float s = (a[0] + a[1]) + (a[2] + a[3]) + (b[0] + b[1]) + (b[2] + b[3]); s += __shfl_xor(s, 16); s += __shfl_xor(s, 32);
            rs[ai][m] = 1.0f / sqrtf(s * (1.f / 2048.f) + EPS); }
}
struct EpiStore {
    bf16_t* O; int ldc; int sig_lo, sig_hi; const float* SS; int hm = 0; const float* RS = nullptr;
    __device__ __forceinline__ bf16_t* hm_dest(int pn, int bj, int row, int c128) const {
        char* ob = (char*)O;
        if (hm == 1) { const int b = row >> 11, s = row & (SEQ - 1);
            if (pn == 4) return (bf16_t*)(ob + (WS_KA - WS_IN)) + ((size_t)(b * 2 + bj) * SEQ + s) * 128 + c128;
            if (pn == 5) return (bf16_t*)(ob + (WS_VA - WS_IN)) + ((size_t)(b * 2 + bj) * SEQ + s) * 128 + c128;
            if (pn == 8 || pn == 9) return (bf16_t*)(ob + (WS_KB - WS_IN)) + ((size_t)(b * 4 + (pn - 8) * 2 + bj) * SEQ + s) * 128 + c128;
            if (pn == 10 || pn == 11) return (bf16_t*)(ob + (WS_VB - WS_IN)) + ((size_t)(b * 4 + (pn - 10) * 2 + bj) * SEQ + s) * 128 + c128;
            return nullptr; }
        if (hm == 2) { const int b = row >> 11, s = row & (SEQ - 1); return (bf16_t*)(ob + (bj == 0 ? 0 : 32 * MiB)) + ((size_t)(b * 4 + pn) * SEQ + s) * 128 + c128; }
        if (hm == 3) { const int l = row >> 12, b = (row >> 8) & 15, s = row & 255; return O + ((size_t)(((l * 16 + b) * 4 + pn) * 2 + bj) * 256 + s) * 128 + c128; }
        return nullptr;
    }
    __device__ __forceinline__ bool operator()(f32x4 (&acc)[2][2][4][2], const GUnit& u, int wr, int wc, int fr, int fq, const float (&prs)[2][4]) const {
        const int row0 = u.pm * BM + wr * 64 + fr, col0 = u.pn * BM + wc * 32 + 8 * fq; const bool sig = u.pn >= sig_lo && u.pn < sig_hi;
        float rs[2][4];
        if (SS) row_scales(SS, row0, fq, rs);
        else if (RS) {
#pragma unroll
            for (int ai = 0; ai < 2; ++ai)
#pragma unroll
                for (int m = 0; m < 4; ++m) rs[ai][m] = prs[ai][m]; }
#pragma unroll
        for (int ai = 0; ai < 2; ++ai)
#pragma unroll
            for (int m = 0; m < 4; ++m) { bf16_t* rowp = (u.pn == 41) ? (bf16_t*)((char*)O + (WS_KR2 - WS_IN)) + (size_t)(row0 + ai * HALF + m * 16) * 256 + wc * 32 + 8 * fq : O + (size_t)(row0 + ai * HALF + m * 16) * ldc + col0;
#pragma unroll
                for (int bj = 0; bj < 2; ++bj) { float v[8];
#pragma unroll
                    for (int j = 0; j < 4; ++j) { v[j] = acc[ai][bj][m][0][j]; v[4 + j] = acc[ai][bj][m][1][j]; }
                    if (SS || RS) {
#pragma unroll
                        for (int j = 0; j < 8; ++j) v[j] *= rs[ai][m]; }
                    if (sig) {
#pragma unroll
                        for (int j = 0; j < 8; ++j) v[j] = fmaxf(sigmoidf_(v[j]), 1e-18f); }
                    bf16_t* hd = hm ? hm_dest(u.pn, bj, row0 + ai * HALF + m * 16, wc * 32 + 8 * fq) : nullptr;
                    if (hd) *(GAS u32x4*)hd = pack8(v); else *(GAS u32x4*)(rowp + bj * HALF) = pack8(v); } }
        return true;
    }
};
struct EpiRes {
    const float* base; float* out;
    __device__ __forceinline__ bool operator()(f32x4 (&acc)[2][2][4][2], const GUnit& u, int wr, int wc, int fr, int fq) const {
        const int row0 = u.pm * BM + wr * 64 + fr, col0 = u.pn * BM + wc * 32 + 8 * fq;
#pragma unroll
        for (int ai = 0; ai < 2; ++ai) { f32x4 bv[4][2][2];
#pragma unroll
            for (int m = 0; m < 4; ++m) { const size_t off = (size_t)(row0 + ai * HALF + m * 16) * DM + col0;
#pragma unroll
                for (int bj = 0; bj < 2; ++bj)
#pragma unroll
                    for (int n = 0; n < 2; ++n) bv[m][bj][n] = *(const GAS f32x4*)(base + off + bj * HALF + 4 * n); }
            __builtin_amdgcn_sched_barrier(0);
#pragma unroll
            for (int m = 0; m < 4; ++m) { const size_t off = (size_t)(row0 + ai * HALF + m * 16) * DM + col0;
#pragma unroll
                for (int bj = 0; bj < 2; ++bj)
#pragma unroll
                    for (int n = 0; n < 2; ++n) *(GAS f32x4*)(out + off + bj * HALF + 4 * n) = bv[m][bj][n] + acc[ai][bj][m][n]; }
            __builtin_amdgcn_sched_barrier(0); }
        return true;
    }
};
struct EpiResX {
    f16_t* X16; float* SS;
    __device__ __forceinline__ bool operator()(f32x4 (&acc)[2][2][4][2], const GUnit& u, int wr, int wc, int fr, int fq) const {
        const int row0 = u.pm * BM + wr * 64 + fr, col0 = u.pn * BM + wc * 32 + 8 * fq;
#pragma unroll
        for (int ai = 0; ai < 2; ++ai) { f16x8 bv[4][2];
#pragma unroll
            for (int m = 0; m < 4; ++m) { const size_t off = (size_t)(row0 + ai * HALF + m * 16) * DM + col0;
#pragma unroll
                for (int bj = 0; bj < 2; ++bj) bv[m][bj] = *(const GAS f16x8*)(X16 + off + bj * HALF); }
            __builtin_amdgcn_sched_barrier(0);
#pragma unroll
            for (int m = 0; m < 4; ++m) { const int row = row0 + ai * HALF + m * 16; const size_t off = (size_t)row * DM + col0; float s = 0.f;
#pragma unroll
                for (int bj = 0; bj < 2; ++bj) { f16x8 h;
#pragma unroll
                    for (int n = 0; n < 2; ++n)
#pragma unroll
                        for (int j = 0; j < 4; ++j) { const float x = (float)bv[m][bj][4 * n + j] + acc[ai][bj][m][n][j]; h[4 * n + j] = (f16_t)x; s += x * x; }
                    *(GAS f16x8*)(X16 + off + bj * HALF) = h; }
                s += __shfl_xor(s, 16); s += __shfl_xor(s, 32);
                if (fq == 0) ((GAS float*)SS)[(size_t)row * 32 + u.pn * 4 + wc] = s; }
            __builtin_amdgcn_sched_barrier(0); }
        return true;
    }
};
struct EpiResF {
    const f16_t* X16; float* out;
    __device__ __forceinline__ bool operator()(f32x4 (&acc)[2][2][4][2], const GUnit& u, int wr, int wc, int fr, int fq) const {
        const int row0 = u.pm * BM + wr * 64 + fr, col0 = u.pn * BM + wc * 32 + 8 * fq;
#pragma unroll
        for (int ai = 0; ai < 2; ++ai) { f16x8 bv[4][2];
#pragma unroll
            for (int m = 0; m < 4; ++m) { const size_t off = (size_t)(row0 + ai * HALF + m * 16) * DM + col0;
#pragma unroll
                for (int bj = 0; bj < 2; ++bj) bv[m][bj] = *(const GAS f16x8*)(X16 + off + bj * HALF); }
            __builtin_amdgcn_sched_barrier(0);
#pragma unroll
            for (int m = 0; m < 4; ++m) { const size_t off = (size_t)(row0 + ai * HALF + m * 16) * DM + col0;
#pragma unroll
                for (int bj = 0; bj < 2; ++bj)
#pragma unroll
                    for (int n = 0; n < 2; ++n) { f32x4 x;
#pragma unroll
                        for (int j = 0; j < 4; ++j) x[j] = (float)bv[m][bj][4 * n + j] + acc[ai][bj][m][n][j];
                        *(GAS f32x4*)(out + off + bj * HALF + 4 * n) = x; } }
            __builtin_amdgcn_sched_barrier(0); }
        return true;
    }
};
struct EpiUkv {
    bf16_t* O; const float* kg; LAS float* xs;
    __device__ __forceinline__ bool operator()(f32x4 (&acc)[2][2][4][2], const GUnit& u, int wr, int wc, int fr, int fq) const {
        const int row0 = u.pm * BM + wr * 64 + fr, c128 = wc * 32 + 8 * fq;
#pragma unroll
        for (int ai = 0; ai < 2; ++ai)
#pragma unroll
            for (int m = 0; m < 4; ++m) { float s = 0.f;
#pragma unroll
                for (int n = 0; n < 2; ++n)
#pragma unroll
                    for (int j = 0; j < 4; ++j) { const float x = acc[ai][0][m][n][j]; s += x * x; }
                s += __shfl_xor(s, 16); s += __shfl_xor(s, 32);
                if (fq == 0) xs[(ai * HALF + wr * 64 + m * 16 + fr) * 4 + wc] = s; }
        asm volatile("s_waitcnt lgkmcnt(0)" ::: "memory"); __builtin_amdgcn_s_barrier(); asm volatile("" ::: "memory");
        const f32x4 g0 = *(const GAS f32x4*)(kg + c128), g1 = *(const GAS f32x4*)(kg + c128 + 4);
#pragma unroll
        for (int ai = 0; ai < 2; ++ai)
#pragma unroll
            for (int m = 0; m < 4; ++m) { const f32x4 p = *(const LAS f32x4*)(xs + (ai * HALF + wr * 64 + m * 16 + fr) * 4);
                const float r = 1.0f / sqrtf(((p[0] + p[1]) + (p[2] + p[3])) * (1.f / 128.f) + EPS);
                const int row = row0 + ai * HALF + m * 16, b = row >> 11, s = row & (SEQ - 1);
                bf16_t* kd = O + ((size_t)(b * 4 + u.pn) * SEQ + s) * 128 + c128; float v[8];
#pragma unroll
                for (int j = 0; j < 4; ++j) { v[j] = acc[ai][0][m][0][j] * r * g0[j]; v[4 + j] = acc[ai][0][m][1][j] * r * g1[j]; }
                *(GAS u32x4*)kd = pack8(v);
#pragma unroll
                for (int j = 0; j < 4; ++j) { v[j] = acc[ai][1][m][0][j]; v[4 + j] = acc[ai][1][m][1][j]; }
                *(GAS u32x4*)(kd + 16 * MiB) = pack8(v); }
        asm volatile("s_waitcnt lgkmcnt(0)" ::: "memory"); __builtin_amdgcn_s_barrier(); asm volatile("" ::: "memory");
        return true;
    }
};
struct EpiSwiglu {
    bf16_t* H; const float* RS;
    __device__ __forceinline__ bool operator()(f32x4 (&acc)[2][2][4][2], const GUnit& u, int wr, int wc, int fr, int fq, const float (&rs)[2][4]) const {
        const int row0 = u.pm * BM + wr * 64 + fr, col0 = u.pn * HALF + wc * 32 + 8 * fq;
#pragma unroll
        for (int ai = 0; ai < 2; ++ai)
#pragma unroll
            for (int m = 0; m < 4; ++m) { float v[8]; const float r = rs[ai][m];
#pragma unroll
                for (int n = 0; n < 2; ++n)
#pragma unroll
                    for (int j = 0; j < 4; ++j) { const float g = acc[ai][0][m][n][j] * r, up = acc[ai][1][m][n][j] * r; v[4 * n + j] = g * sigmoidf_(g) * up; }
                *(GAS u32x4*)(H + (size_t)(row0 + ai * HALF + m * 16) * DFF + col0) = pack8(v); }
        return true;
    }
};
struct EpiBranch {
    const bf16_t* G; bf16_t* O;
    __device__ __forceinline__ bool operator()(f32x4 (&acc)[2][2][4][2], const GUnit& u, int wr, int wc, int fr, int fq) const {
        const int row0 = u.pm * BM + wr * 64 + fr, col0 = u.pn * BM + wc * 32 + 8 * fq; const int seg = u.seg;
        const int cn = (seg == 2 ? 2 : seg) * DM, cd = (seg == 2 ? 2 : seg + 1) * DM;
#pragma unroll
        for (int ai = 0; ai < 2; ++ai) { bf16x8 gn[4][2], gd[4][2];
#pragma unroll
            for (int m = 0; m < 4; ++m) { const size_t goff = (size_t)(row0 + ai * HALF + m * 16) * LDI + col0;
#pragma unroll
                for (int bj = 0; bj < 2; ++bj) { gn[m][bj] = *(const GAS bf16x8*)(G + goff + cn + bj * HALF); gd[m][bj] = *(const GAS bf16x8*)(G + goff + cd + bj * HALF); } }
            __builtin_amdgcn_sched_barrier(0);
#pragma unroll
            for (int m = 0; m < 4; ++m)
#pragma unroll
                for (int bj = 0; bj < 2; ++bj) { float f[8];
                    if (seg < 2) {
#pragma unroll
                        for (int j = 0; j < 8; ++j) f[j] = bf2f(gn[m][bj][j]) * fast_rcp(bf2f(gd[m][bj][j])); }
                    else {
#pragma unroll
                        for (int j = 0; j < 8; ++j) f[j] = bf2f(gn[m][bj][j]); }
#pragma unroll
                    for (int j = 0; j < 4; ++j) { acc[ai][bj][m][0][j] *= f[j]; acc[ai][bj][m][1][j] *= f[4 + j]; }
                    if (seg == 2) { float v[8];
#pragma unroll
                        for (int j = 0; j < 4; ++j) { v[j] = acc[ai][bj][m][0][j]; v[4 + j] = acc[ai][bj][m][1][j]; }
                        *(GAS u32x4*)(O + (size_t)(row0 + ai * HALF + m * 16) * DM + col0 + bj * HALF) = pack8(v); } }
            __builtin_amdgcn_sched_barrier(0); }
        return seg == 2;
    }
};

template <class Epi> struct EpiHook {
    __device__ __forceinline__ void prefetch(const Epi&, const GUnit&, int, int, LAS unsigned char*) {}
    __device__ __forceinline__ bool call(const Epi& E, f32x4 (&acc)[2][2][4][2], const GUnit& u, int wr, int wc, int fr, int fq, LAS unsigned char*) { return E(acc, u, wr, wc, fr, fq); }
};
template <class Epi> struct EpiHookRS {
    __device__ __forceinline__ void prefetch(const Epi& E, const GUnit& u, int wr, int lane, LAS unsigned char* wl) {
        if (E.RS) { const float* p = E.RS + u.pm * BM + wr * 64 + lane;
            __builtin_amdgcn_global_load_lds((const unsigned*)p, (LAS unsigned*)wl, 4, 0, 0);
            __builtin_amdgcn_global_load_lds((const unsigned*)(p + HALF), (LAS unsigned*)(wl + 256), 4, 0, 0); }
    }
    __device__ __forceinline__ bool call(const Epi& E, f32x4 (&acc)[2][2][4][2], const GUnit& u, int wr, int wc, int fr, int fq, LAS unsigned char* wl) {
        float rs[2][4];
#pragma unroll
        for (int ai = 0; ai < 2; ++ai)
#pragma unroll
            for (int m = 0; m < 4; ++m) rs[ai][m] = E.RS ? *(const LAS float*)(wl + ai * 256 + (m * 16 + fr) * 4) : 1.f;
        return E(acc, u, wr, wc, fr, fq, rs);
    }
};
template <> struct EpiHook<EpiStore> : EpiHookRS<EpiStore> {};
template <> struct EpiHook<EpiSwiglu> : EpiHookRS<EpiSwiglu> {};
template <bool F16> __device__ __forceinline__ f32x4 mma16(bf16x8 b, bf16x8 a, f32x4 c) {
    if constexpr (F16) return __builtin_amdgcn_mfma_f32_16x16x32_f16(__builtin_bit_cast(f16x8, b), __builtin_bit_cast(f16x8, a), c, 0, 0, 0);
    else return __builtin_amdgcn_mfma_f32_16x16x32_bf16(b, a, c, 0, 0, 0);
}
template <class Epi, class Sched, bool ALIGN_EPI, bool SP2, bool F16 = false>
__device__ __forceinline__ void gemm_phase(LAS unsigned char* lds, const int lda, const int ldb, const Sched& S, const Epi& E) {
    int tid = threadIdx.x; asm volatile("" : "+v"(tid));
    const int wid = __builtin_amdgcn_readfirstlane(tid >> 6), lane = tid & 63, wr = wid >> 2, wc = wid & 3, fr = lane & 15, fq = lane >> 4;
    unsigned voffA[2], voffB[2];
#pragma unroll
    for (int i = 0; i < 2; ++i) { int R, C; stage_rc(tid * 16 + i * 8192, R, C); const int Rb = (R & ~31) + perm32(R & 31);
        voffA[i] = (unsigned)(R * lda + C) * 2u; voffB[i] = (unsigned)(Rb * ldb + C) * 2u; }
    const size_t kstep = (size_t)(BK * 2);
    const size_t hstepA = (size_t)HALF * lda * 2, hstepB = (size_t)HALF * ldb * 2;
    const unsigned ldsw = (unsigned)wid * 1024u;
    const int aoff = lds_byte(wr * 64 + fr, fq * 8), boff = lds_byte(wc * 32 + fr, fq * 8);
#define PG8_SA(b, h) (((b) * 2 + (h)) * HTB)
#define PG8_SB(b, h) ((4 + (b) * 2 + (h)) * HTB)
    const unsigned ldsb = (unsigned)(unsigned long long)lds + ldsw;
#define PG8_STAGE(bufoff, gbase, voff) do { _Pragma("unroll") for (int _i = 0; _i < 2; ++_i) \
        asm volatile("s_mov_b32 m0, %2\n\ts_nop 0\n\tglobal_load_lds_dwordx4 %0, %1" :: "v"((voff)[_i]), "s"((const char*)(gbase)), "s"(ldsb + (unsigned)((bufoff) + _i * 8192)) : "memory"); } while (0)
#define PG8_LDA(dst, b, h) do { _Pragma("unroll") for (int m = 0; m < 4; ++m) _Pragma("unroll") for (int k = 0; k < 2; ++k) dst[m][k] = *(const LAS bf16x8*)(lds + PG8_SA(b, h) + aoff + m * 2048 + k * 1024); } while (0)
#define PG8_LDB(dst, b, h) do { _Pragma("unroll") for (int n = 0; n < 2; ++n) _Pragma("unroll") for (int k = 0; k < 2; ++k) dst[n][k] = *(const LAS bf16x8*)(lds + PG8_SB(b, h) + boff + n * 2048 + k * 1024); } while (0)
#define PG8_MMA(ai, bj, At, Bt) do { __builtin_amdgcn_s_setprio(1); _Pragma("unroll") for (int m = 0; m < 4; ++m) _Pragma("unroll") for (int n = 0; n < 2; ++n) _Pragma("unroll") for (int k = 0; k < 2; ++k) \
        acc[ai][bj][m][n] = mma16<F16>(Bt[n][k], At[m][k], acc[ai][bj][m][n]); __builtin_amdgcn_s_setprio(0); } while (0)
#define PG8_WAIT_V(n) asm volatile("s_waitcnt vmcnt(" #n ")" ::: "memory")
#define PG8_WAIT_L(n) asm volatile("s_waitcnt lgkmcnt(" #n ")" ::: "memory")
#define PG8_BAR __builtin_amdgcn_s_barrier()
#define PG8_SCHED __builtin_amdgcn_sched_barrier(0)
    GUnit cur, nxt; int ui = 0;
    if (!S.next(0, cur)) return;
    EpiHook<Epi> HK; LAS unsigned char* const rswl = lds + RS_LDS_OFF + wid * 512; HK.prefetch(E, cur, wr, lane, rswl);
    f32x4 acc[2][2][4][2];
#pragma unroll
    for (int a = 0; a < 2; ++a)
#pragma unroll
        for (int b = 0; b < 2; ++b)
#pragma unroll
            for (int m = 0; m < 4; ++m)
#pragma unroll
                for (int n = 0; n < 2; ++n) acc[a][b][m][n] = (f32x4){0.f, 0.f, 0.f, 0.f};
    bf16x8 At[4][2], B0[2][2], B1[2][2];
    const char* cA = cur.A; const char* cB = cur.B;
    if constexpr (SP2) {
        PG8_STAGE(PG8_SB(0, 0), cB, voffB); PG8_STAGE(PG8_SB(0, 1), cB + hstepB, voffB); PG8_STAGE(PG8_SA(0, 0), cA, voffA); PG8_STAGE(PG8_SA(0, 1), cA + hstepA, voffA);
        if (wr == 1) PG8_BAR;
        PG8_WAIT_V(2); PG8_BAR;
        PG8_STAGE(PG8_SB(1, 0), cB + kstep, voffB); PG8_STAGE(PG8_SA(1, 0), cA + kstep, voffA); PG8_STAGE(PG8_SB(1, 1), cB + hstepB + kstep, voffB);
        PG8_WAIT_V(6); PG8_BAR;
    } else {
        PG8_STAGE(PG8_SB(0, 0), cB, voffB); PG8_STAGE(PG8_SA(0, 0), cA, voffA); PG8_STAGE(PG8_SB(0, 1), cB + hstepB, voffB); PG8_STAGE(PG8_SA(0, 1), cA + hstepA, voffA);
        if (wr == 1) PG8_BAR;
        PG8_WAIT_V(4); PG8_BAR;
        PG8_STAGE(PG8_SB(1, 0), cB + kstep, voffB); PG8_STAGE(PG8_SA(1, 0), cA + kstep, voffA); PG8_STAGE(PG8_SB(1, 1), cB + hstepB + kstep, voffB);
        PG8_WAIT_V(6); PG8_BAR;
    }
    for (;;) {
        const bool has_next = S.next(ui + 1, nxt);
        const char* nA = has_next ? nxt.A : cA; const char* nB = has_next ? nxt.B : cB;
        const int nt = cur.nt;
        for (int t = 0; t < nt; t += 2) {
            const bool last = (t == nt - 2);
            const char* a1 = cA + (size_t)(t + 1) * kstep;
            const char* a2 = last ? nA : cA + (size_t)(t + 2) * kstep; const char* b2 = last ? nB : cB + (size_t)(t + 2) * kstep;
            const char* a3 = a2 + kstep; const char* b3 = b2 + kstep;
            if constexpr (SP2) {
            PG8_LDB(B0, 0, 0); PG8_LDB(B1, 0, 1); PG8_SCHED; PG8_LDA(At, 0, 0); PG8_STAGE(PG8_SA(1, 1), a1 + hstepA, voffA);
            PG8_WAIT_V(8); PG8_WAIT_L(0); PG8_BAR; PG8_MMA(0, 0, At, B0); PG8_MMA(0, 1, At, B1); PG8_BAR; PG8_SCHED;
            PG8_LDA(At, 0, 1); PG8_STAGE(PG8_SB(0, 0), b2, voffB); PG8_STAGE(PG8_SB(0, 1), b2 + hstepB, voffB); PG8_STAGE(PG8_SA(0, 0), a2, voffA);
            PG8_WAIT_V(8); PG8_WAIT_L(0); PG8_BAR; PG8_MMA(1, 0, At, B0); PG8_MMA(1, 1, At, B1); PG8_BAR; PG8_SCHED;
            PG8_LDB(B0, 1, 0); PG8_LDB(B1, 1, 1); PG8_SCHED; PG8_LDA(At, 1, 0); PG8_STAGE(PG8_SA(0, 1), a2 + hstepA, voffA);
            PG8_WAIT_V(8); PG8_WAIT_L(0); PG8_BAR; PG8_MMA(0, 0, At, B0); PG8_MMA(0, 1, At, B1); PG8_BAR; PG8_SCHED;
            PG8_LDA(At, 1, 1); PG8_STAGE(PG8_SB(1, 0), b3, voffB); PG8_STAGE(PG8_SB(1, 1), b3 + hstepB, voffB); PG8_STAGE(PG8_SA(1, 0), a3, voffA);
            PG8_WAIT_V(8); PG8_WAIT_L(0); PG8_BAR; PG8_MMA(1, 0, At, B0); PG8_MMA(1, 1, At, B1); PG8_BAR; PG8_SCHED;
            } else {
            PG8_LDB(B0, 0, 0); PG8_SCHED; PG8_LDA(At, 0, 0); PG8_STAGE(PG8_SA(1, 1), a1 + hstepA, voffA);
            PG8_WAIT_L(8); PG8_BAR; PG8_WAIT_L(0); PG8_MMA(0, 0, At, B0); PG8_BAR; PG8_SCHED;
            PG8_LDB(B1, 0, 1); PG8_STAGE(PG8_SB(0, 0), b2, voffB);
            PG8_BAR; PG8_WAIT_L(0); PG8_MMA(0, 1, At, B1); PG8_BAR;
            PG8_LDA(At, 0, 1); PG8_STAGE(PG8_SA(0, 0), a2, voffA);
            PG8_BAR; PG8_WAIT_L(0); PG8_MMA(1, 0, At, B0); PG8_BAR; PG8_SCHED;
            PG8_STAGE(PG8_SB(0, 1), b2 + hstepB, voffB);
            PG8_WAIT_V(6); PG8_BAR; PG8_MMA(1, 1, At, B1); PG8_BAR;
            PG8_LDB(B0, 1, 0); PG8_SCHED; PG8_LDA(At, 1, 0); PG8_STAGE(PG8_SA(0, 1), a2 + hstepA, voffA);
            PG8_WAIT_L(8); PG8_BAR; PG8_WAIT_L(0); PG8_MMA(0, 0, At, B0); PG8_BAR; PG8_SCHED;
            PG8_LDB(B1, 1, 1); PG8_STAGE(PG8_SB(1, 0), b3, voffB);
            PG8_BAR; PG8_WAIT_L(0); PG8_MMA(0, 1, At, B1); PG8_BAR;
            PG8_LDA(At, 1, 1); PG8_STAGE(PG8_SA(1, 0), a3, voffA);
            PG8_BAR; PG8_WAIT_L(0); PG8_MMA(1, 0, At, B0); PG8_BAR; PG8_SCHED;
            PG8_STAGE(PG8_SB(1, 1), b3 + hstepB, voffB);
            PG8_WAIT_V(6); PG8_BAR; PG8_MMA(1, 1, At, B1); PG8_BAR;
            }
        }
        if constexpr (ALIGN_EPI) { if (wr == 0) PG8_BAR; }
        const bool zero = HK.call(E, acc, cur, wr, wc, fr, fq, rswl);
        if (!has_next) break;
        if (zero) {
#pragma unroll
        for (int a = 0; a < 2; ++a)
#pragma unroll
            for (int b = 0; b < 2; ++b)
#pragma unroll
                for (int m = 0; m < 4; ++m)
#pragma unroll
                    for (int n = 0; n < 2; ++n) acc[a][b][m][n] = (f32x4){0.f, 0.f, 0.f, 0.f};
        }
        cur = nxt; cA = nA; cB = nB; ++ui; HK.prefetch(E, cur, wr, lane, rswl);
        if constexpr (ALIGN_EPI) { if (wr == 1) PG8_BAR; }
    }
    PG8_WAIT_V(0);
    if constexpr (!ALIGN_EPI) { if (wr == 0) PG8_BAR; }
    PG8_BAR;
#undef PG8_SA
#undef PG8_SB
#undef PG8_STAGE
#undef PG8_LDA
#undef PG8_LDB
#undef PG8_MMA
#undef PG8_WAIT_V
#undef PG8_WAIT_L
#undef PG8_BAR
#undef PG8_SCHED
}
}

#define XB_TMO      128
#define XB_XCNT(j)  (256  + 64 * (j))
#define XB_XSUB(j)  (1280 + 64 * (j))
#define XB_XGEN(j)  (2304 + 64 * (j))
#define XB_TOP      3328
#define XB_TOPGEN   3392
#define XCD_BAR_WORDS 3456
#define XB_SPIN_CAP (1u << 18)
__device__ __forceinline__ unsigned xb_ld(unsigned* p)              { return __hip_atomic_load(p, __ATOMIC_RELAXED, __HIP_MEMORY_SCOPE_AGENT); }
__device__ __forceinline__ unsigned xb_add(unsigned* p, unsigned v) { return __hip_atomic_fetch_add(p, v, __ATOMIC_RELAXED, __HIP_MEMORY_SCOPE_AGENT); }
__device__ __forceinline__ unsigned xb_xcc_id() { return (unsigned)__builtin_amdgcn_s_getreg((3 << 11) | 20) & 0xFu; }
#define XB_SPIN(cond, bar) do { unsigned _sp = 0; while (cond) { __builtin_amdgcn_s_sleep(1); \
    if ((++_sp & 255u) == 0u) { if (xb_ld(&(bar)[XB_TMO])) break; if (_sp > XB_SPIN_CAP) { atomicAdd(&(bar)[XB_TMO], 1u); break; } } } } while (0)
struct XcdBarrier { unsigned* bar; unsigned x; volatile LAS unsigned* st; };
__device__ __forceinline__ XcdBarrier xcd_barrier_post(unsigned* bar, volatile LAS unsigned* st) {
    XcdBarrier b; b.bar = bar; b.x = xb_xcc_id(); b.st = st;
    if (threadIdx.x == 0) (void)xb_add(&bar[XB_XCNT(b.x)], 1u);
    return b;
}
__device__ __forceinline__ void xcd_barrier_complete(unsigned* bar, unsigned x, unsigned& nloc, unsigned& nx) {
    const unsigned G = gridDim.x * gridDim.y * gridDim.z;
    unsigned sum, cnt, mine, sp = 0u;
    for (;;) {
        sum = 0u; cnt = 0u; mine = 0u;
#pragma unroll
        for (unsigned j = 0; j < 16; ++j) { const unsigned c = xb_ld(&bar[XB_XCNT(j)]); sum += c; cnt += (c > 0u) ? 1u : 0u; mine = (j == x) ? c : mine; }
        if (sum == G) break;
        __builtin_amdgcn_s_sleep(1);
        if ((++sp & 255u) == 0u) { if (xb_ld(&bar[XB_TMO])) break; if (sp > XB_SPIN_CAP) { atomicAdd(&bar[XB_TMO], 1u); break; } }
    }
    nloc = mine > 0u ? mine : 1u; nx = cnt > 0u ? cnt : 1u;
}
__device__ __forceinline__ void xcd_barrier(const XcdBarrier& b) {
    asm volatile("s_waitcnt vmcnt(0)" ::: "memory");
    __syncthreads();
    if (threadIdx.x == 0) {
        unsigned* bar = b.bar;
        __builtin_amdgcn_s_waitcnt(0);
        unsigned nloc = b.st[0], nx = b.st[1];
        if (nloc == 0u) { xcd_barrier_complete(bar, b.x, nloc, nx); b.st[0] = nloc; b.st[1] = nx; }
        const unsigned old = xb_add(&bar[XB_XSUB(b.x)], 1u);
        const unsigned gen = old / nloc;
        if (old + 1u == (gen + 1u) * nloc) {
            __builtin_amdgcn_fence(__ATOMIC_RELEASE, "agent");
            asm volatile("s_waitcnt vmcnt(0)" ::: "memory");
            const unsigned og = xb_add(&bar[XB_TOP], 1u);
            const unsigned tg = og / nx;
            if (og + 1u == (tg + 1u) * nx) xb_add(&bar[XB_TOPGEN], 1u);
            else XB_SPIN(xb_ld(&bar[XB_TOPGEN]) == tg, bar);
            __builtin_amdgcn_fence(__ATOMIC_ACQUIRE, "agent");
            xb_add(&bar[XB_XGEN(b.x)], 1u);
            asm volatile("s_waitcnt vmcnt(0)" ::: "memory");
        } else {
            XB_SPIN(xb_ld(&bar[XB_XGEN(b.x)]) == gen, bar);
            __builtin_amdgcn_fence(__ATOMIC_ACQUIRE, "agent");
            asm volatile("s_waitcnt vmcnt(0)" ::: "memory");
        }
    }
    __syncthreads();
}
constexpr int CW_BAR = 4096;

struct Args { const float* in[27]; const int* pos; float* out; unsigned char* ws; int ph_lo, ph_hi; };

struct Frame {
    LAS unsigned char* lds; int tid, lane, wave, G, gw, NGW;
};

__device__ __forceinline__ int map_src_col(int maptype, int n0) {
    if (maptype == 0) return n0;
    if (maptype == 1) { if (n0 < 4096) return n0; if (n0 < 10240) return n0 + 64; if (n0 < 10304) return n0 - 6144; return -1; }
    const int pn = n0 >> 8, r = n0 & 255; return r < 128 ? 128 * pn + r : DFF + 128 * pn + (r - 128);
}
__device__ __forceinline__ void transpose_item(const float* W, int K, int Nsrc, bf16_t* WT, int nblk, const float* gain, int maptype, LAS float* scr, int item, int lane) {
    const int kb = item / nblk, nb = item % nblk, k0 = 64 * kb, n0 = 32 * nb;
    const bool f16o = (maptype & 4) != 0; maptype &= 3;
    const int sc0 = map_src_col(maptype, n0);
    float v[32];
    if (sc0 >= 0) { const GAS float* src = (const GAS float*)W + (size_t)(k0 + (lane >> 5)) * Nsrc + sc0 + (lane & 31);
#pragma unroll
        for (int i = 0; i < 32; ++i) v[i] = src[(size_t)(2 * i) * Nsrc]; }
    else {
#pragma unroll
        for (int i = 0; i < 32; ++i) v[i] = 0.f; }
#pragma unroll
    for (int i = 0; i < 32; ++i) scr[(2 * i + (lane >> 5)) * 33 + (lane & 31)] = v[i];
    LDS_WAIT(); asm volatile("" ::: "memory");
    const int c = lane & 7;
    f32x4 g0 = (f32x4){1.f, 1.f, 1.f, 1.f}, g1 = g0;
    if (gain) { g0 = *(const GAS f32x4*)(gain + k0 + 8 * c); g1 = *(const GAS f32x4*)(gain + k0 + 8 * c + 4); }
#pragma unroll
    for (int j = 0; j < 4; ++j) { const int n = (lane >> 3) + 8 * j; const LAS float* s = scr + (8 * c) * 33 + n;
        if (f16o) { f16x8 h; h[0] = (f16_t)(s[0 * 33] * g0.x); h[1] = (f16_t)(s[1 * 33] * g0.y); h[2] = (f16_t)(s[2 * 33] * g0.z); h[3] = (f16_t)(s[3 * 33] * g0.w);
            h[4] = (f16_t)(s[4 * 33] * g1.x); h[5] = (f16_t)(s[5 * 33] * g1.y); h[6] = (f16_t)(s[6 * 33] * g1.z); h[7] = (f16_t)(s[7 * 33] * g1.w);
            *(GAS f16x8*)(WT + (size_t)(n0 + n) * K + k0 + 8 * c) = h; }
        else {
        u32x4 o; o.x = cvt_pk_bf16(s[0 * 33] * g0.x, s[1 * 33] * g0.y); o.y = cvt_pk_bf16(s[2 * 33] * g0.z, s[3 * 33] * g0.w); o.z = cvt_pk_bf16(s[4 * 33] * g1.x, s[5 * 33] * g1.y); o.w = cvt_pk_bf16(s[6 * 33] * g1.z, s[7 * 33] * g1.w);
        *(GAS u32x4*)(WT + (size_t)(n0 + n) * K + k0 + 8 * c) = o; } }
    LDS_WAIT(); asm volatile("" ::: "memory");
}
struct ConvJob { const float* W; int K, Nsrc; bf16_t* WT; int Nd; const float* gain; int maptype; };
__device__ __forceinline__ int conv_items(const ConvJob& j) { return (j.K / 64) * (j.Nd / 32); }

template <int U> __device__ __forceinline__ void rms_rows(const float* x, bf16_t* o, int r0, int lane) {
    f32x4 v[U][8];
#pragma unroll
    for (int u = 0; u < U; ++u) { const GAS f32x4* xr = (const GAS f32x4*)(x + (size_t)(r0 + u) * DM) + lane;
#pragma unroll
        for (int j = 0; j < 8; ++j) v[u][j] = xr[64 * j]; }
#pragma unroll
    for (int u = 0; u < U; ++u) { float s = 0.f;
#pragma unroll
        for (int j = 0; j < 8; ++j) s += (v[u][j].x * v[u][j].x + v[u][j].y * v[u][j].y) + (v[u][j].z * v[u][j].z + v[u][j].w * v[u][j].w);
        const float r = 1.0f / sqrtf(wave_sum(s) * (1.f / 2048.f) + EPS);
        GAS u32x2* op = (GAS u32x2*)(o + (size_t)(r0 + u) * DM) + lane;
#pragma unroll
        for (int j = 0; j < 8; ++j) { u32x2 w; w.x = cvt_pk_bf16(v[u][j].x * r, v[u][j].y * r); w.y = cvt_pk_bf16(v[u][j].z * r, v[u][j].w * r); op[64 * j] = w; } }
}
template <int U> __device__ __forceinline__ void cvt_rows(const float* x, f16_t* o16, float* RS, int r0, int lane) {
    f32x4 v[U][8];
#pragma unroll
    for (int u = 0; u < U; ++u) { const GAS f32x4* xr = (const GAS f32x4*)(x + (size_t)(r0 + u) * DM) + lane;
#pragma unroll
        for (int j = 0; j < 8; ++j) v[u][j] = xr[64 * j]; }
#pragma unroll
    for (int u = 0; u < U; ++u) { float s = 0.f;
#pragma unroll
        for (int j = 0; j < 8; ++j) s += (v[u][j].x * v[u][j].x + v[u][j].y * v[u][j].y) + (v[u][j].z * v[u][j].z + v[u][j].w * v[u][j].w);
        s = wave_sum(s);
        if (lane == 0) ((GAS float*)RS)[r0 + u] = 1.0f / sqrtf(s * (1.f / 2048.f) + EPS);
        typedef _Float16 f16x4 __attribute__((ext_vector_type(4))); GAS f16x4* hp = (GAS f16x4*)(o16 + (size_t)(r0 + u) * DM) + lane;
#pragma unroll
        for (int j = 0; j < 8; ++j) { f16x4 h; h[0] = (f16_t)v[u][j].x; h[1] = (f16_t)v[u][j].y; h[2] = (f16_t)v[u][j].z; h[3] = (f16_t)v[u][j].w; hp[64 * j] = h; } }
}
__device__ __forceinline__ void reduce_ss(const float* SS, float* RS, int idx, int nthr) {
    for (int i = idx; i < M * 4; i += nthr) { const int row = i >> 2, q = i & 3; const GAS f32x4* p = (const GAS f32x4*)(SS + (size_t)row * 32 + q * 8); const f32x4 a = p[0], b = p[1];
        float s = (a[0] + a[1]) + (a[2] + a[3]) + (b[0] + b[1]) + (b[2] + b[3]); s += __shfl_xor(s, 1); s += __shfl_xor(s, 2);
        if (q == 0) ((GAS float*)RS)[row] = 1.0f / sqrtf(s * (1.f / 2048.f) + EPS); }
}
template <int GL> __device__ __forceinline__ float group_sum(float v) {
#pragma unroll
    for (int o = 1; o < GL; o <<= 1) v += __shfl_xor(v, o);
    return v;
}
struct G8 { float g[8]; };
__device__ __forceinline__ G8 ld_gain8(const float* p) { G8 r; const f32x4 a = *(const GAS f32x4*)p, b = *(const GAS f32x4*)(p + 4); r.g[0] = a[0]; r.g[1] = a[1]; r.g[2] = a[2]; r.g[3] = a[3]; r.g[4] = b[0]; r.g[5] = b[1]; r.g[6] = b[2]; r.g[7] = b[3]; return r; }
__device__ __forceinline__ G8 ones8() { G8 r;
#pragma unroll
    for (int j = 0; j < 8; ++j) r.g[j] = 1.f; return r; }
template <int GL> __device__ __forceinline__ u32x4 norm8(bf16x8 x, const G8& gn, float scale) {
    float f[8], s = 0.f;
#pragma unroll
    for (int j = 0; j < 8; ++j) { f[j] = bf2f(x[j]); s += f[j] * f[j]; }
    s = group_sum<GL>(s); const float r = scale / sqrtf(s * (1.f / (8 * GL)) + EPS);
#pragma unroll
    for (int j = 0; j < 8; ++j) f[j] = f[j] * r * gn.g[j];
    return pack8(f);
}
__device__ __forceinline__ u32x4 scale8(bf16x8 x, float scale) { float f[8];
#pragma unroll
    for (int j = 0; j < 8; ++j) f[j] = bf2f(x[j]) * scale;
    return pack8(f); }
__device__ __forceinline__ u32x4 norm_rope8(bf16x8 x, bf16x8 x2, const G8& gn, float scale, const f32x4* cs  , int c) {
    float f[8], s = 0.f;
#pragma unroll
    for (int j = 0; j < 8; ++j) { f[j] = bf2f(x[j]) + bf2f(x2[j]); s += f[j] * f[j]; }
    s = group_sum<8>(s); const float r = 1.0f / sqrtf(s * (1.f / 64.f) + EPS);
    float o[8];
#pragma unroll
    for (int j = 0; j < 8; ++j) f[j] = f[j] * r * gn.g[j];
#pragma unroll
    for (int j = 0; j < 8; ++j) { const float xp = __shfl_xor(f[j], 4); const float cv = cs[j >> 1][2 * (j & 1)], sv = cs[j >> 1][2 * (j & 1) + 1];
        o[j] = ((c < 4) ? (f[j] * cv - xp * sv) : (xp * sv + f[j] * cv)) * scale; }
    return pack8(o);
}

namespace att {
#define KSWZ(row, colB) ((row) * 256 + ((colB) ^ (((row) & 7) << 4)))
#define K2SWZ(row, colB) ((row) * 128 + ((colB) ^ ((((row) >> 1) & 7) << 4)))
#define SBAR() __builtin_amdgcn_sched_barrier(0)
constexpr int A_V = 0, A_K = 32768, A_K2 = 65536;
constexpr int A_WS = LDSCTL_OFF + 2048, A_TAB = LDSCTL_OFF + 4096;
__device__ __forceinline__ int v_st(int k, int c) { const int kk = (k & ~0xC) | ((k & 4) << 1) | ((k & 8) >> 1); return ((kk >> 3) * 4 + (c >> 5)) * 512 + ((kk & 7) * 32 + (c & 31)) * 2; }
__device__ __forceinline__ int v_rd_base(int lane) { return ((lane & 3) << 3) | (((lane >> 2) & 3) << 6) | (((lane >> 4) & 1) << 5) | (((lane >> 5) & 1) << 8); }
constexpr int v_rd_off(int d0, int ks, int half) { return d0 * 512 + ks * 4096 + half * 2048; }
template <int OFF> __device__ __forceinline__ s16x4 tr_read(int vb) {
    s16x4 r; asm volatile("ds_read_b64_tr_b16 %0, %1 offset:%2" : "=&v"(r) : "v"(vb), "i"(OFF) : "memory"); return r;
}
template <int D0> __device__ __forceinline__ void pv_one(f32x16& od, int vb, bf16x8 pa0, bf16x8 pa1, bf16x8 pa2, bf16x8 pa3) {
    const s16x4 l0 = tr_read<v_rd_off(D0, 0, 0)>(vb), h0 = tr_read<v_rd_off(D0, 0, 1)>(vb), l1 = tr_read<v_rd_off(D0, 1, 0)>(vb), h1 = tr_read<v_rd_off(D0, 1, 1)>(vb);
    const s16x4 l2 = tr_read<v_rd_off(D0, 2, 0)>(vb), h2 = tr_read<v_rd_off(D0, 2, 1)>(vb), l3 = tr_read<v_rd_off(D0, 3, 0)>(vb), h3 = tr_read<v_rd_off(D0, 3, 1)>(vb);
    asm volatile("s_waitcnt lgkmcnt(0)" ::: "memory"); SBAR();
#define PK(L, H) (bf16x8){L[0], L[1], L[2], L[3], H[0], H[1], H[2], H[3]}
    od = __builtin_amdgcn_mfma_f32_32x32x16_bf16(pa0, PK(l0, h0), od, 0, 0, 0);
    od = __builtin_amdgcn_mfma_f32_32x32x16_bf16(pa1, PK(l1, h1), od, 0, 0, 0);
    od = __builtin_amdgcn_mfma_f32_32x32x16_bf16(pa2, PK(l2, h2), od, 0, 0, 0);
    od = __builtin_amdgcn_mfma_f32_32x32x16_bf16(pa3, PK(l3, h3), od, 0, 0, 0);
#undef PK
}
__device__ __forceinline__ float xhalf_max(float v) { auto rr = __builtin_amdgcn_permlane32_swap(__float_as_uint(v), __float_as_uint(v), false, false); return fmaxf(__uint_as_float(rr[0]), __uint_as_float(rr[1])); }
__device__ __forceinline__ float xhalf_sum(float v) { auto rr = __builtin_amdgcn_permlane32_swap(__float_as_uint(v), __float_as_uint(v), false, false); return __uint_as_float(rr[0]) + __uint_as_float(rr[1]); }
constexpr int crow0(int r) { return (r & 3) + 8 * (r >> 2); }

template <int KOFF> __device__ __forceinline__ float sb_half_prod(f32x16& p, const float base, const int dq4, const int hi) {
    float keep[16];
#pragma unroll
    for (int r = 0; r < 16; ++r) { const float e = fast_exp2(fminf(-p[r] * LOG2E, 100.f)), b = fast_rcp(1.f + e); const bool v = KOFF + crow0(r) < dq4; keep[r] = v ? e * b : 1.f; p[r] = v ? b : 0.f; }
    float gh1[4], gh0[4];
#pragma unroll
    for (int g = 0; g < 4; ++g) { const float own = (keep[4 * g] * keep[4 * g + 1]) * (keep[4 * g + 2] * keep[4 * g + 3]);
        auto rr = __builtin_amdgcn_permlane32_swap(__float_as_uint(own), __float_as_uint(own), false, false);
        const float other = __uint_as_float(hi ? rr[0] : rr[1]); gh1[g] = hi ? own : other; gh0[g] = hi ? other : own; }
    float R = base;
#pragma unroll
    for (int g = 3; g >= 0; --g) { float w = hi ? R : R * gh1[g];
        const float b3 = p[4 * g + 3], b2 = p[4 * g + 2], b1 = p[4 * g + 1], b0 = p[4 * g];
        p[4 * g + 3] = b3 * w; w *= keep[4 * g + 3]; p[4 * g + 2] = b2 * w; w *= keep[4 * g + 2]; p[4 * g + 1] = b1 * w; w *= keep[4 * g + 1]; p[4 * g] = b0 * w;
        R = R * (gh1[g] * gh0[g]); }
    return R;
}

template <int MODE>
__device__ __forceinline__ void attn_unit(LAS unsigned char* lds, const bf16_t* Qb, int ldq, const bf16_t* Kb, int ldk, const bf16_t* K2b, const bf16_t* Vb, int ldv, bf16_t* Ob, int ldo,
                                          int q0, float sink2, const float* qgain, const f32x4* rope_rows  ) {
    int tid = threadIdx.x; asm volatile("" : "+v"(tid));
    const int wid = __builtin_amdgcn_readfirstlane(tid >> 6), lane = tid & 63, r32 = lane & 31, hi = lane >> 5;
    constexpr int ND = (MODE == 2) ? 12 : 8;
    bf16x8 qr[ND];
    { const bf16_t* Qw = Qb + (size_t)(wid * 32 + r32) * ldq + hi * 8;
#pragma unroll
      for (int d0 = 0; d0 < ND; ++d0) qr[d0] = *(const GAS bf16x8*)(Qw + d0 * 16);
      constexpr float QSC = (MODE == 1) ? 0.08838834764831845f : (MODE == 2 ? 0.07216878364870323f * LOG2E : 0.08838834764831845f * LOG2E);
      f32x4 gq[8][2], gr[2][4], rcs[2][4];
      if (MODE != 1) {
#pragma unroll
          for (int d0 = 0; d0 < 8; ++d0) { gq[d0][0] = *(const GAS f32x4*)(qgain + d0 * 16 + hi * 8); gq[d0][1] = *(const GAS f32x4*)(qgain + d0 * 16 + hi * 8 + 4); } }
      if (MODE == 2) { const GAS f32x4* rp = (const GAS f32x4*)rope_rows + (size_t)(wid * 32 + r32) * 16;
#pragma unroll
          for (int dd = 0; dd < 2; ++dd) { gr[dd][0] = *(const GAS f32x4*)(qgain + 128 + dd * 16 + hi * 8); gr[dd][1] = *(const GAS f32x4*)(qgain + 128 + dd * 16 + hi * 8 + 4);
              gr[dd][2] = *(const GAS f32x4*)(qgain + 160 + dd * 16 + hi * 8); gr[dd][3] = *(const GAS f32x4*)(qgain + 160 + dd * 16 + hi * 8 + 4);
#pragma unroll
              for (int q = 0; q < 4; ++q) rcs[dd][q] = rp[8 * dd + 4 * hi + q]; } }
      __builtin_amdgcn_sched_barrier(0);
      float rn = QSC, rr = QSC;
      if (MODE != 1) { float s = 0.f;
#pragma unroll
          for (int d0 = 0; d0 < 8; ++d0)
#pragma unroll
              for (int j = 0; j < 8; ++j) { const float f = bf2f(qr[d0][j]); s += f * f; }
          s = xhalf_sum(s); rn = QSC / sqrtf(s * (1.f / 128.f) + EPS);
          if (MODE == 2) { float s2 = 0.f;
#pragma unroll
              for (int d0 = 8; d0 < ND; ++d0)
#pragma unroll
                  for (int j = 0; j < 8; ++j) { const float f = bf2f(qr[d0][j]); s2 += f * f; }
              s2 = xhalf_sum(s2); rr = QSC / sqrtf(s2 * (1.f / 64.f) + EPS); } }
#pragma unroll
      for (int d0 = 0; d0 < 8; ++d0) { float f[8];
          if (MODE != 1) { const f32x4 g0 = gq[d0][0], g1 = gq[d0][1];
#pragma unroll
              for (int j = 0; j < 4; ++j) { f[j] = bf2f(qr[d0][j]) * rn * g0[j]; f[4 + j] = bf2f(qr[d0][4 + j]) * rn * g1[j]; } }
          else {
#pragma unroll
              for (int j = 0; j < 8; ++j) f[j] = bf2f(qr[d0][j]) * rn; }
          qr[d0] = __builtin_bit_cast(bf16x8, pack8(f)); }
      if (MODE == 2) {
#pragma unroll
          for (int dd = 0; dd < 2; ++dd) { float x1[8], x2[8], o1[8], o2[8];
              const f32x4 ga = gr[dd][0], gb = gr[dd][1], gc = gr[dd][2], gd = gr[dd][3];
#pragma unroll
              for (int j = 0; j < 4; ++j) { x1[j] = bf2f(qr[(MODE == 2 ? 8 : 0) + dd][j]) * rr * ga[j]; x1[4 + j] = bf2f(qr[(MODE == 2 ? 8 : 0) + dd][4 + j]) * rr * gb[j];
                  x2[j] = bf2f(qr[(MODE == 2 ? 10 : 0) + dd][j]) * rr * gc[j]; x2[4 + j] = bf2f(qr[(MODE == 2 ? 10 : 0) + dd][4 + j]) * rr * gd[j]; }
#pragma unroll
              for (int j = 0; j < 8; ++j) { const f32x4 cs = rcs[dd][j >> 1]; const float cv = cs[2 * (j & 1)], sv = cs[2 * (j & 1) + 1];
                  o1[j] = x1[j] * cv - x2[j] * sv; o2[j] = x1[j] * sv + x2[j] * cv; }
              qr[(MODE == 2 ? 8 : 0) + dd] = __builtin_bit_cast(bf16x8, pack8(o1)); qr[(MODE == 2 ? 10 : 0) + dd] = __builtin_bit_cast(bf16x8, pack8(o2)); }
      }
    }
    const int qw = q0 + wid * 32;
    int jt0, jt1;
    if (MODE == 0) { jt0 = (q0 >> 6) - 2; jt0 = jt0 < 0 ? 0 : jt0; jt1 = (q0 >> 6) + 3; }
    else if (MODE == 3) { jt0 = 0; jt1 = 3; }
    else { jt0 = 0; jt1 = (q0 >> 6) + 3; }
    const int NT = jt1 - jt0 + 1;
    const int sr = tid >> 4, sc = (tid & 15) * 8, vst0 = v_st(sr, sc), vst1 = v_st(32 + sr, sc), kst0 = KSWZ(sr, sc * 2), kst1 = KSWZ(32 + sr, sc * 2);
    const int s2r = tid >> 3, s2c = (tid & 7) * 8, k2st = K2SWZ(s2r, s2c * 2);
    bf16x8 sk0, sk1, sv0, sv1, sk2;
#define SLOAD(kt) do { const size_t kr0 = (size_t)((kt) * 64 + sr); sk0 = *(const GAS bf16x8*)(Kb + kr0 * ldk + sc); sk1 = *(const GAS bf16x8*)(Kb + (kr0 + 32) * ldk + sc); \
        sv0 = *(const GAS bf16x8*)(Vb + kr0 * ldv + sc); sv1 = *(const GAS bf16x8*)(Vb + (kr0 + 32) * ldv + sc); \
        if (MODE == 2) sk2 = *(const GAS bf16x8*)(K2b + (size_t)((kt) * 64 + s2r) * 64 + s2c); } while (0)
#define SWRITE(b) do { *(LAS bf16x8*)(lds + A_V + (b) * 16384 + vst0) = sv0; *(LAS bf16x8*)(lds + A_V + (b) * 16384 + vst1) = sv1; \
        *(LAS bf16x8*)(lds + A_K + (b) * 16384 + kst0) = sk0; *(LAS bf16x8*)(lds + A_K + (b) * 16384 + kst1) = sk1; \
        if (MODE == 2) *(LAS bf16x8*)(lds + A_K2 + (b) * 8192 + k2st) = sk2; } while (0)
#define TILE(j) (MODE == 1 ? jt1 - (j) : jt0 + (j))
    const int vb0 = (int)(unsigned)(uintptr_t)(lds + A_V) + v_rd_base(lane);
    LAS float* wsf = (LAS float*)(lds + A_WS) + wid * 64;
    const LAS float* tab = (const LAS float*)(lds + A_TAB);
    f32x16 o[4];
#pragma unroll
    for (int d = 0; d < 4; ++d)
#pragma unroll
        for (int r = 0; r < 16; ++r) o[d][r] = 0.f;
    float m_reg = (MODE == 0) ? sink2 : -1e30f, l_reg = (MODE == 0) ? 1.f : 0.f, carry = 1.f;

    bf16x8 tk0, tk1, tv0, tv1, tk2;
#define SLOADB(kt) do { const size_t kr0 = (size_t)((kt) * 64 + sr); tk0 = *(const GAS bf16x8*)(Kb + kr0 * ldk + sc); tk1 = *(const GAS bf16x8*)(Kb + (kr0 + 32) * ldk + sc); \
        tv0 = *(const GAS bf16x8*)(Vb + kr0 * ldv + sc); tv1 = *(const GAS bf16x8*)(Vb + (kr0 + 32) * ldv + sc); \
        if (MODE == 2) tk2 = *(const GAS bf16x8*)(K2b + (size_t)((kt) * 64 + s2r) * 64 + s2c); } while (0)
#define SWRITEB(b) do { *(LAS bf16x8*)(lds + A_V + (b) * 16384 + vst0) = tv0; *(LAS bf16x8*)(lds + A_V + (b) * 16384 + vst1) = tv1; \
        *(LAS bf16x8*)(lds + A_K + (b) * 16384 + kst0) = tk0; *(LAS bf16x8*)(lds + A_K + (b) * 16384 + kst1) = tk1; \
        if (MODE == 2) *(LAS bf16x8*)(lds + A_K2 + (b) * 8192 + k2st) = tk2; } while (0)
    auto compute = [&](const int j, const int buf) __attribute__((always_inline)) {
        const int kt = TILE(j), k0 = kt * 64;
        bool need;
        if (MODE == 0) need = (k0 + 63 >= qw - 127) && (k0 <= qw + 31);
        else if (MODE == 3) need = true;
        else need = (k0 <= qw + 31);
        if (need) {
            f32x16 p0, p1;
#pragma unroll
            for (int r = 0; r < 16; ++r) { p0[r] = 0.f; p1[r] = 0.f; }
            { const LAS unsigned char* Kt = lds + A_K + buf * 16384;
#pragma unroll
              for (int d0 = 0; d0 < 8; ++d0) { const int cb = (d0 * 16 + hi * 8) * 2;
                  const bf16x8 a0 = *(const LAS bf16x8*)(Kt + KSWZ(r32, cb)), a1 = *(const LAS bf16x8*)(Kt + KSWZ(32 + r32, cb));
                  p0 = __builtin_amdgcn_mfma_f32_32x32x16_bf16(a0, qr[d0], p0, 0, 0, 0); p1 = __builtin_amdgcn_mfma_f32_32x32x16_bf16(a1, qr[d0], p1, 0, 0, 0); }
              if (MODE == 2) { const LAS unsigned char* K2t = lds + A_K2 + buf * 8192;
#pragma unroll
                  for (int d2 = 0; d2 < 4; ++d2) { const int cb = (d2 * 16 + hi * 8) * 2;
                      const bf16x8 a0 = *(const LAS bf16x8*)(K2t + K2SWZ(r32, cb)), a1 = *(const LAS bf16x8*)(K2t + K2SWZ(32 + r32, cb));
                      p0 = __builtin_amdgcn_mfma_f32_32x32x16_bf16(a0, qr[(MODE == 2 ? 8 : 0) + d2], p0, 0, 0, 0); p1 = __builtin_amdgcn_mfma_f32_32x32x16_bf16(a1, qr[(MODE == 2 ? 8 : 0) + d2], p1, 0, 0, 0); } } }
            const int dq4 = qw + r32 - k0 - 4 * hi;
            if (MODE == 1) {
                carry = sb_half_prod<32>(p1, carry, dq4, hi);
                carry = sb_half_prod<0>(p0, carry, dq4, hi);
            } else {
                if (MODE == 0) {
#pragma unroll
                    for (int r = 0; r < 16; ++r) { p0[r] += tab[dq4 + 96 - crow0(r)]; p1[r] += tab[dq4 + 96 - 32 - crow0(r)]; }
                }
                if (MODE == 2) { if (k0 + 63 > qw) {
#pragma unroll
                    for (int r = 0; r < 16; ++r) { if (crow0(r) > dq4) p0[r] = -1e30f; if (32 + crow0(r) > dq4) p1[r] = -1e30f; } } }
                float pmax = p0[0];
#pragma unroll
                for (int r = 1; r < 16; ++r) pmax = fmaxf(pmax, p0[r]);
#pragma unroll
                for (int r = 0; r < 16; ++r) pmax = fmaxf(pmax, p1[r]);
                pmax = xhalf_max(pmax);
                const float mn = fmaxf(m_reg, pmax), alpha = fast_exp2(m_reg - mn); m_reg = mn;
                float ps = 0.f;
#pragma unroll
                for (int r = 0; r < 16; ++r) { p0[r] = fast_exp2(p0[r] - mn); p1[r] = fast_exp2(p1[r] - mn); ps += p0[r] + p1[r]; }
                ps = xhalf_sum(ps);
                l_reg = l_reg * alpha + ps;
                if (__any(alpha < 1.f)) { if (hi == 0) wsf[r32] = alpha; asm volatile("s_waitcnt lgkmcnt(0)" ::: "memory");
#pragma unroll
                    for (int r = 0; r < 16; ++r) { const float a = wsf[crow0(r) + 4 * hi];
#pragma unroll
                        for (int d = 0; d < 4; ++d) o[d][r] *= a; }
                    asm volatile("s_waitcnt lgkmcnt(0)" ::: "memory"); }
            }
            bf16x8 pa0, pa1, pa2, pa3;
#define PK4(P, BASE, OUT) do { unsigned a0 = cvt_pk_bf16(P[BASE + 0], P[BASE + 1]), a1 = cvt_pk_bf16(P[BASE + 2], P[BASE + 3]); \
    unsigned b0 = cvt_pk_bf16(P[BASE + 4], P[BASE + 5]), b1 = cvt_pk_bf16(P[BASE + 6], P[BASE + 7]); \
    auto r0 = __builtin_amdgcn_permlane32_swap(a0, b0, false, false); auto r1 = __builtin_amdgcn_permlane32_swap(a1, b1, false, false); \
    u32x4 w = {r0[0], r1[0], r0[1], r1[1]}; OUT = __builtin_bit_cast(bf16x8, w); } while (0)
            PK4(p0, 0, pa0); PK4(p0, 8, pa1); PK4(p1, 0, pa2); PK4(p1, 8, pa3);
#undef PK4
            const int vb = vb0 + buf * 16384;
            pv_one<0>(o[0], vb, pa0, pa1, pa2, pa3); pv_one<1>(o[1], vb, pa0, pa1, pa2, pa3); pv_one<2>(o[2], vb, pa0, pa1, pa2, pa3); pv_one<3>(o[3], vb, pa0, pa1, pa2, pa3);
        }
    };
    SLOAD(TILE(0)); SWRITE(0); __syncthreads();
    if (NT > 1) SLOAD(TILE(1));
    if (NT > 2) SLOADB(TILE(2));
    for (int j = 0; j < NT; j += 2) {
        compute(j, 0);
        if (j + 1 < NT) { SWRITE(1); if (j + 3 < NT) SLOAD(TILE(j + 3)); }
        __syncthreads();
        if (j + 1 < NT) {
            compute(j + 1, 1);
            if (j + 2 < NT) { SWRITEB(0); if (j + 4 < NT) SLOADB(TILE(j + 4)); }
            __syncthreads();
        }
    }
    LAS float* ot = (LAS float*)(lds + wid * 16384);
#pragma unroll
    for (int d = 0; d < 4; ++d)
#pragma unroll
        for (int r = 0; r < 16; ++r) ot[(crow0(r) + 4 * hi) * 128 + d * 32 + r32] = o[d][r];
    if (MODE != 1) { if (hi == 0) wsf[r32] = l_reg; }
    asm volatile("s_waitcnt lgkmcnt(0)" ::: "memory");
#pragma unroll
    for (int i = 0; i < 8; ++i) { const int row = i * 4 + (lane >> 4), c8 = lane & 15;
        const f32x4 a = *(const LAS f32x4*)(ot + row * 128 + c8 * 8), b = *(const LAS f32x4*)(ot + row * 128 + c8 * 8 + 4);
        const float rl = (MODE != 1) ? 1.f / wsf[row] : 1.f;
        float v[8] = {a[0] * rl, a[1] * rl, a[2] * rl, a[3] * rl, b[0] * rl, b[1] * rl, b[2] * rl, b[3] * rl};
        *(GAS u32x4*)(Ob + (size_t)(wid * 32 + row) * ldo + c8 * 8) = pack8(v); }
    __syncthreads();
#undef SLOAD
#undef SWRITE
#undef SLOADB
#undef SWRITEB
#undef TILE
}

__device__ __forceinline__ void swa_band_unit(LAS unsigned char* lds, const bf16_t* Qg, int ldq, const bf16_t* Kh, const bf16_t* Vh, bf16_t* Og, int ldo, int q0, int h0,
                                              const float* sinks, const float* qgain, const LAS float* tabs) {
    int tid = threadIdx.x; asm volatile("" : "+v"(tid));
    const int wid = __builtin_amdgcn_readfirstlane(tid >> 6), lane = tid & 63, r32 = lane & 31, hi = lane >> 5;
    const int t0 = (q0 >> 6) - 2;
    { const int sr = tid >> 4, sc = (tid & 15) * 8, vst0 = v_st(sr, sc), vst1 = v_st(32 + sr, sc), kst0 = KSWZ(sr, sc * 2), kst1 = KSWZ(32 + sr, sc * 2);
      bf16x8 sk[4][2], sv[4][2];
#pragma unroll
      for (int tt = 0; tt < 4; ++tt) { const int kt = t0 + tt; if (kt >= 0) { const size_t kr0 = (size_t)(kt * 64 + sr);
          sk[tt][0] = *(const GAS bf16x8*)(Kh + kr0 * 128 + sc); sk[tt][1] = *(const GAS bf16x8*)(Kh + (kr0 + 32) * 128 + sc);
          sv[tt][0] = *(const GAS bf16x8*)(Vh + kr0 * 128 + sc); sv[tt][1] = *(const GAS bf16x8*)(Vh + (kr0 + 32) * 128 + sc); } }
#pragma unroll
      for (int tt = 0; tt < 4; ++tt) { const int kt = t0 + tt; if (kt >= 0) {
          *(LAS bf16x8*)(lds + tt * 16384 + kst0) = sk[tt][0]; *(LAS bf16x8*)(lds + tt * 16384 + kst1) = sk[tt][1];
          *(LAS bf16x8*)(lds + 65536 + tt * 16384 + vst0) = sv[tt][0]; *(LAS bf16x8*)(lds + 65536 + tt * 16384 + vst1) = sv[tt][1]; } }
    }
    __syncthreads();
    const int vb0 = (int)(unsigned)(uintptr_t)(lds + 65536) + v_rd_base(lane);
    LAS float* wsf = (LAS float*)(lds + A_WS) + wid * 64;
    for (int pass = 0; pass < 2; ++pass) {
        const int task = wid + 8 * pass, g = task >> 2, rbk = task & 3, qw = q0 + rbk * 32;
        bf16x8 qr[8];
        { const bf16_t* Qw = Qg + (size_t)(rbk * 32 + r32) * ldq + g * 128 + hi * 8;
#pragma unroll
          for (int d0 = 0; d0 < 8; ++d0) qr[d0] = *(const GAS bf16x8*)(Qw + d0 * 16);
          f32x4 gq[8][2];
#pragma unroll
          for (int d0 = 0; d0 < 8; ++d0) { gq[d0][0] = *(const GAS f32x4*)(qgain + d0 * 16 + hi * 8); gq[d0][1] = *(const GAS f32x4*)(qgain + d0 * 16 + hi * 8 + 4); }
          __builtin_amdgcn_sched_barrier(0);
          float s = 0.f;
#pragma unroll
          for (int d0 = 0; d0 < 8; ++d0)
#pragma unroll
              for (int j = 0; j < 8; ++j) { const float f = bf2f(qr[d0][j]); s += f * f; }
          s = xhalf_sum(s); const float rn = (0.08838834764831845f * LOG2E) / sqrtf(s * (1.f / 128.f) + EPS);
#pragma unroll
          for (int d0 = 0; d0 < 8; ++d0) { float f[8];
#pragma unroll
              for (int j = 0; j < 4; ++j) { f[j] = bf2f(qr[d0][j]) * rn * gq[d0][0][j]; f[4 + j] = bf2f(qr[d0][4 + j]) * rn * gq[d0][1][j]; }
              qr[d0] = __builtin_bit_cast(bf16x8, pack8(f)); } }
        f32x16 o[4];
#pragma unroll
        for (int d = 0; d < 4; ++d)
#pragma unroll
            for (int r = 0; r < 16; ++r) o[d][r] = 0.f;
        float m_reg = ((const GAS float*)sinks)[h0 + g] * LOG2E, l_reg = 1.f;
        const LAS float* tab = tabs + (h0 + g) * 320;
        for (int tt = 0; tt < 4; ++tt) { const int kt = t0 + tt, k0 = kt * 64;
            if (kt < 0 || k0 + 63 < qw - 127 || k0 > qw + 31) continue;
            f32x16 p0, p1;
#pragma unroll
            for (int r = 0; r < 16; ++r) { p0[r] = 0.f; p1[r] = 0.f; }
            { const LAS unsigned char* Kt = lds + tt * 16384;
#pragma unroll
              for (int d0 = 0; d0 < 8; ++d0) { const int cb = (d0 * 16 + hi * 8) * 2;
                  const bf16x8 a0 = *(const LAS bf16x8*)(Kt + KSWZ(r32, cb)), a1 = *(const LAS bf16x8*)(Kt + KSWZ(32 + r32, cb));
                  p0 = __builtin_amdgcn_mfma_f32_32x32x16_bf16(a0, qr[d0], p0, 0, 0, 0); p1 = __builtin_amdgcn_mfma_f32_32x32x16_bf16(a1, qr[d0], p1, 0, 0, 0); } }
            const int dq4 = qw + r32 - k0 - 4 * hi;
#pragma unroll
            for (int r = 0; r < 16; ++r) { p0[r] += tab[dq4 + 96 - crow0(r)]; p1[r] += tab[dq4 + 96 - 32 - crow0(r)]; }
            float pmax = p0[0];
#pragma unroll
            for (int r = 1; r < 16; ++r) pmax = fmaxf(pmax, p0[r]);
#pragma unroll
            for (int r = 0; r < 16; ++r) pmax = fmaxf(pmax, p1[r]);
            pmax = xhalf_max(pmax);
            const float mn = fmaxf(m_reg, pmax), alpha = fast_exp2(m_reg - mn); m_reg = mn;
            float ps = 0.f;
#pragma unroll
            for (int r = 0; r < 16; ++r) { p0[r] = fast_exp2(p0[r] - mn); p1[r] = fast_exp2(p1[r] - mn); ps += p0[r] + p1[r]; }
            ps = xhalf_sum(ps);
            l_reg = l_reg * alpha + ps;
            if (__any(alpha < 1.f)) { if (hi == 0) wsf[r32] = alpha; asm volatile("s_waitcnt lgkmcnt(0)" ::: "memory");
#pragma unroll
                for (int r = 0; r < 16; ++r) { const float a = wsf[crow0(r) + 4 * hi];
#pragma unroll
                    for (int d = 0; d < 4; ++d) o[d][r] *= a; }
                asm volatile("s_waitcnt lgkmcnt(0)" ::: "memory"); }
            bf16x8 pa0, pa1, pa2, pa3;
#define PK4(P, BASE, OUT) do { unsigned a0 = cvt_pk_bf16(P[BASE + 0], P[BASE + 1]), a1 = cvt_pk_bf16(P[BASE + 2], P[BASE + 3]); \
    unsigned b0 = cvt_pk_bf16(P[BASE + 4], P[BASE + 5]), b1 = cvt_pk_bf16(P[BASE + 6], P[BASE + 7]); \
    auto r0 = __builtin_amdgcn_permlane32_swap(a0, b0, false, false); auto r1 = __builtin_amdgcn_permlane32_swap(a1, b1, false, false); \
    u32x4 w = {r0[0], r1[0], r0[1], r1[1]}; OUT = __builtin_bit_cast(bf16x8, w); } while (0)
            PK4(p0, 0, pa0); PK4(p0, 8, pa1); PK4(p1, 0, pa2); PK4(p1, 8, pa3);
#undef PK4
            const int vb = vb0 + tt * 16384;
            pv_one<0>(o[0], vb, pa0, pa1, pa2, pa3); pv_one<1>(o[1], vb, pa0, pa1, pa2, pa3); pv_one<2>(o[2], vb, pa0, pa1, pa2, pa3); pv_one<3>(o[3], vb, pa0, pa1, pa2, pa3);
        }
        if (hi == 0) wsf[r32] = l_reg; asm volatile("s_waitcnt lgkmcnt(0)" ::: "memory");
#pragma unroll
        for (int r = 0; r < 16; ++r) { const int row = crow0(r) + 4 * hi; const float rl = 1.f / wsf[row];
            GAS unsigned short* op = (GAS unsigned short*)(Og + (size_t)(rbk * 32 + row) * ldo + g * 128 + r32);
#pragma unroll
            for (int d = 0; d < 4; ++d) op[d * 32] = (unsigned short)(cvt_pk_bf16(o[d][r] * rl, 0.f) & 0xffffu); }
        asm volatile("s_waitcnt lgkmcnt(0)" ::: "memory");
    }
    __syncthreads();
}
#undef KSWZ
#undef K2SWZ
#undef SBAR
}

struct SchedXkv { pg8::TileOrder T; const char* A; const char* B;
    __device__ bool next(int i, pg8::GUnit& u) const { const long L = (long)i * T.G + T.c; if (L >= 256) return false; const int l = (int)L >> 6, r = (int)L & 63, pm = r >> 2, pn = r & 3;
        u.A = A + (size_t)pm * 256 * DM * 2; u.B = B + (size_t)l * 4 * MiB + (size_t)pn * 256 * DM * 2; u.nt = 32; u.pm = l * 16 + pm; u.pn = pn; u.seg = 0; return true; } };
__device__ __forceinline__ unsigned long long pt_ld(LAS unsigned char* lds, int k) {
    asm volatile("" ::: "memory");
    const unsigned long long v = ((const LAS unsigned long long*)(lds + PT_OFF))[k];
    const unsigned lo = __builtin_amdgcn_readfirstlane((unsigned)v), hi = __builtin_amdgcn_readfirstlane((unsigned)(v >> 32));
    return ((unsigned long long)hi << 32) | lo;
}
#define INP(k) ((const float*)pt_ld(F.lds, (k)))
#define WSP() ((unsigned char*)pt_ld(F.lds, 28))
#define OUTP() ((float*)pt_ld(F.lds, 27))
__global__ void __launch_bounds__(NWAVES * 64, 2) trunk_fwd(Args args) {
    extern __shared__ __attribute__((aligned(16))) unsigned char lds_raw[];
    Frame F;
    F.lds = (LAS unsigned char*)lds_raw;
    volatile LAS unsigned* MISC = (volatile LAS unsigned*)(F.lds + MISC_OFF);
    F.tid = threadIdx.x; F.lane = F.tid & 63; F.wave = __builtin_amdgcn_readfirstlane(F.tid >> 6);
    F.G = gridDim.x; const int bx = blockIdx.x; const int vcu = (F.G % 8 == 0) ? (bx % 8) * (F.G / 8) + bx / 8 : bx;
    F.gw = vcu * NWAVES + F.wave; F.NGW = F.G * NWAVES;
    for (int u = F.tid; u < (LDS_BYTES - LDSCTL_OFF) / 4; u += NWAVES * 64) ((LAS unsigned*)(F.lds + LDSCTL_OFF))[u] = 0u;
    __syncthreads();
    if (F.tid == 0) { LAS unsigned long long* PT = (LAS unsigned long long*)(F.lds + PT_OFF);
#pragma unroll
        for (int k = 0; k < 27; ++k) PT[k] = (unsigned long long)args.in[k];
        PT[27] = (unsigned long long)args.out; PT[28] = (unsigned long long)args.ws; }
    __syncthreads();
    const int lo = args.ph_lo, hi = args.ph_hi;
    const bool use_bar = (hi - lo) > 1;
    XcdBarrier bar; bar.bar = (unsigned*)(WSP() + WS_CTL) + CW_BAR; bar.x = 0; bar.st = nullptr;
    if (use_bar) bar = xcd_barrier_post((unsigned*)(WSP() + WS_CTL) + CW_BAR, MISC + 8);
#define IN(k) (lo <= (k) && (k) < hi)
#define SEAM(k) do { if (IN(k) && IN((k) + 1)) xcd_barrier(bar); } while (0)
#define WSB(off) ((bf16_t*)(ws + (off)))
    LAS float* scr = (LAS float*)(F.lds + F.wave * 16384);

#define PHASE_PROLOG(lv) int LN = threadIdx.x & 63; asm volatile("" : "+v"(LN)); int LQ = (lv); asm volatile("" : "+s"(LQ)); int BX = blockIdx.x; asm volatile("" : "+s"(BX)); \
    int GG = gridDim.x; asm volatile("" : "+s"(GG)); const int VC = (GG % 8 == 0) ? (BX % 8) * (GG / 8) + BX / 8 : BX, GW = VC * NWAVES + F.wave, NGW = GG * NWAVES; (void)LN; (void)LQ; (void)GW; (void)NGW; (void)VC;
    if (PHON(18) && IN(0)) { PHASE_PROLOG(0)
        unsigned char* ws = WSP();
        for (int l = 0; l < DEPTH; ++l) {
            const int nit = (2048 / 64) * (1024 / 32);
            for (int it = GW; it < nit; it += NGW)
                transpose_item(INP(20) + (size_t)l * 2048 * 1024, 2048, 1024, WSB(WS_WXKV + (size_t)l * 4 * MiB), 1024 / 32, INP(18) + l * 2048, 0, scr, it, LN);
        }
        const float* mem = INP(1);
        for (int r0 = GW * 2; r0 < MMEM; r0 += NGW * 2) rms_rows<2>(mem, WSB(WS_MEMN), r0, LN);
        { const GAS int* positions = (const GAS int*)INP(2); GAS f32x2* ROPE = (GAS f32x2*)(ws + WS_ROPE);
          for (int idx = GW * 64 + LN; idx < M * 32; idx += NGW * 64) { const int row = idx >> 5, i = idx & 31;
              const float inv = exp2f(-(float)i * (13.287712379549449f / 32.f)); float sn, cs; sincosf((float)positions[row] * inv, &sn, &cs); ROPE[idx] = (f32x2){cs, sn}; } }
    }
    SEAM(0);
    if (PHON(19) && IN(1)) { PHASE_PROLOG(0)
        unsigned char* ws = WSP();
        SchedXkv S; S.T.G = GG; S.T.c = BX; S.A = (const char*)WSB(WS_MEMN); S.B = (const char*)(ws + WS_WXKV);
        pg8::EpiStore E{WSB(WS_XKV), 1024, 0, 0, nullptr, 3};
        pg8::gemm_phase<pg8::EpiStore, SchedXkv, true, true>(F.lds, DM, DM, S, E);
    }
    SEAM(1);
    if (PHON(20) && IN(2)) { PHASE_PROLOG(0)
        unsigned char* ws = WSP(); const float* g = INP(22);
        for (int r = GW; r < DEPTH * MMEM; r += NGW) { const int l = r / MMEM; const int h = LN >> 4, c = LN & 15; const int bb = (r >> 8) & 15, ss = r & 255;
            bf16_t* p = WSB(WS_XKV) + ((size_t)(((l * 16 + bb) * 4 + h) * 2 + 0) * 256 + ss) * 128 + c * 8; const G8 gn = ld_gain8(g + l * 128 + c * 8); *(GAS u32x4*)p = norm8<16>(*(const GAS bf16x8*)p, gn, 1.f); }
    }
    SEAM(2);

    for (int l = 0; l < DEPTH; ++l) {
        const int P = NPRE + l * NP;
        if (PHON(0) && IN(P + 0)) { PHASE_PROLOG(l)
            unsigned char* ws = WSP(); unsigned char* WL = ws + WS_WL;
#define CJ(wi, K_, Ns_, off_, Nd_, gi, mt) { const int n = ((K_) / 64) * ((Nd_) / 32); if (r >= 0 && r < n) { const float* gn = (gi) >= 0 ? INP((gi) < 0 ? 0 : (gi)) + (size_t)LQ * (K_) : nullptr; \
                transpose_item(INP(wi) + (size_t)LQ * (K_) * (Ns_), (K_), (Ns_), (bf16_t*)(WL + (off_)), (Nd_) / 32, gn, (mt), scr, r, LN); } r -= n; }
            constexpr int TOTAL = (2048 / 64) * (LDI / 32) + (2048 / 64) * (2 * DFF / 32) + (DFF / 64) * (2048 / 32) + 2 * (2048 / 64) * (2048 / 32) + (2048 / 64) * (512 / 32) + (512 / 64) * (2048 / 32) + (512 / 64) * (1024 / 32) + (512 / 64) * (768 / 32);
            for (int it = GW; it < TOTAL; it += NGW) { int r = it;
                CJ(5, 2048, IN_W, WL_IN, LDI, 4, 1 | 4)
                CJ(25, 2048, 2 * DFF, WL_GU, 2 * DFF, 24, 2 | 4)
                CJ(26, DFF, 2048, WL_DN, 2048, -1, 0)
                CJ(15, 2048, 2048, WL_BR, 2048, -1, 0)
                CJ(16, 2048, 2048, WL_OUT, 2048, -1, 0)
                CJ(19, 2048, 512, WL_XQ, 512, 17, 0 | 4)
                CJ(23, 512, 2048, WL_XO, 2048, -1, 0)
                CJ(12, 512, 1024, WL_UKV, 1024, 10, 0)
                CJ(11, 512, 768, WL_UQ, 768, 9, 0)
            }
#undef CJ
            if (LQ == 0) { const float* xcur = INP(0); for (int r0 = GW * 4; r0 < M; r0 += NGW * 4) cvt_rows<4>(xcur, (f16_t*)(ws + WS_X16), (float*)(ws + WS_RS), r0, LN); }
            else reduce_ss((const float*)(ws + WS_SS), (float*)(ws + WS_RS), GW * 64 + LN, NGW * 64);
        }
        SEAM(P + 0);
        if (PHON(1) && IN(P + 1)) { PHASE_PROLOG(l)
            unsigned char* ws = WSP();
            pg8::SchedIn S; S.init(WSB(WS_X16), WSB(WS_WL + WL_IN), GG, BX);
            pg8::EpiStore E{WSB(WS_IN), LDI, C_G / 256, C_KR / 256, nullptr, 1, (const float*)(ws + WS_RS)};
            pg8::gemm_phase<pg8::EpiStore, pg8::SchedIn, true, true, true>(F.lds, DM, DM, S, E);
        }
        SEAM(P + 1);
        if (PHON(2) && IN(P + 2)) { PHASE_PROLOG(l)
            unsigned char* ws = WSP(); bf16_t* INb = WSB(WS_IN); bf16_t* KR = WSB(WS_KR); const bf16_t* KR2 = WSB(WS_KR2); bf16_t* KAc = WSB(WS_KA);
            const float* gk = INP(7) + LQ * 128; const float* kg = INP(14) + LQ * 192;
            const int c16 = LN & 15, h4 = LN >> 4; const GAS f32x4* ROPE = (const GAS f32x4*)(ws + WS_ROPE);
            const G8 gk8 = ld_gain8(gk + c16 * 8), gr8 = ld_gain8(kg + 128 + (LN & 7) * 8), one = ones8();
            constexpr int U = 4;
            for (int r0 = GW * U; r0 < M; r0 += NGW * U) {
                bf16x8 kav[U], cqv[U], ckvv[U], krv[U], kr2[U]; f32x4 cs[U][4];
#pragma unroll
                for (int u = 0; u < U; ++u) { const bf16_t* row = INb + (size_t)(r0 + u) * LDI;
                    kav[u] = *(const GAS bf16x8*)(KAc + ((size_t)(((r0 + u) >> 11) * 2 + (h4 & 1)) * SEQ + ((r0 + u) & (SEQ - 1))) * 128 + c16 * 8);
                    cqv[u] = *(const GAS bf16x8*)(row + C_CQ + LN * 8); ckvv[u] = *(const GAS bf16x8*)(row + C_CKV + LN * 8); krv[u] = *(const GAS bf16x8*)(row + C_KR + (LN & 7) * 8); kr2[u] = *(const GAS bf16x8*)(KR2 + (size_t)(r0 + u) * 256 + (LN & 7) * 8);
#pragma unroll
                    for (int q = 0; q < 4; ++q) cs[u][q] = ROPE[(size_t)(r0 + u) * 16 + (LN & 3) * 4 + q]; }
#pragma unroll
                for (int u = 0; u < U; ++u) { bf16_t* row = INb + (size_t)(r0 + u) * LDI;
                    { const u32x4 w = norm8<16>(kav[u], gk8, 1.f); if (LN < 32) *(GAS u32x4*)(KAc + ((size_t)(((r0 + u) >> 11) * 2 + h4) * SEQ + ((r0 + u) & (SEQ - 1))) * 128 + c16 * 8) = w; }
                    *(GAS u32x4*)(row + C_CQ + LN * 8) = norm8<64>(cqv[u], one, 1.f);
                    *(GAS u32x4*)(row + C_CKV + LN * 8) = norm8<64>(ckvv[u], one, 1.f);
                    { const u32x4 w = norm_rope8(krv[u], kr2[u], gr8, 1.f, cs[u], LN & 7); if (LN < 8) *(GAS u32x4*)(KR + (size_t)(r0 + u) * 64 + LN * 8) = w; } }
            }
        }
        SEAM(P + 2);
        if (PHON(3) && IN(P + 3)) { PHASE_PROLOG(l)
            { unsigned char* ws = WSP(); pg8::SchedSimple S; S.init(WSB(WS_IN) + C_CQ, LDI, WSB(WS_WL + WL_UQ), 512, M, 768, 512, GG, GG - 1 - BX);
              pg8::EpiStore E{WSB(WS_QC), 768, 0, 0, nullptr};
              pg8::gemm_phase<pg8::EpiStore, pg8::SchedSimple, true, true>(F.lds, LDI, 512, S, E); }
            { unsigned char* ws = WSP(); pg8::SchedSimple S; S.init(WSB(WS_IN) + C_CKV, LDI, WSB(WS_WL + WL_UKV), 512, M, 1024, 512, GG, BX);
              pg8::EpiUkv E{WSB(WS_KVC), INP(14) + LQ * 192, (LAS float*)(F.lds + LDSCTL_OFF + 6144)};
              pg8::gemm_phase<pg8::EpiUkv, pg8::SchedSimple, true, true>(F.lds, LDI, 512, S, E); }
        }
        SEAM(P + 3);
        if (PHON(5) && IN(P + 5)) { PHASE_PROLOG(l)
            for (int u = VC; u < BATCH * 16; u += GG) { const int pr = u & 3, h = (u >> 2) & 3, b = u >> 4; const size_t rb = (size_t)b * SEQ;
                for (int ps = 0; ps < 2; ++ps) { const int q0 = (ps == 0 ? 7 - pr : pr) * 256; unsigned char* ws = WSP();
                    att::attn_unit<1>(F.lds, WSB(WS_IN) + (rb + q0) * LDI + C_QB + h * 128, LDI, WSB(WS_KB) + (size_t)(b * 4 + h) * SEQ * 128, 128, nullptr, WSB(WS_VB) + (size_t)(b * 4 + h) * SEQ * 128, 128,
                                      WSB(WS_XN) + (rb + q0) * DM + 1024 + h * 128, DM, q0, 0.f, nullptr, nullptr); } }
            { { int tid = threadIdx.x; asm volatile("" : "+v"(tid));
                const GAS float* rel_bias = (const GAS float*)INP(3);
                if (tid < 320) { const int rel = tid - 96; int bk = 0; const bool inw = rel >= 0 && rel < 128;
                    if (inw) { if (rel < 16) bk = rel; else { bk = 16 + (int)(logf((float)rel / 16.f) / logf(8.f) * 16.f); bk = bk > 31 ? 31 : bk; } }
#pragma unroll
                    for (int hh = 0; hh < 8; ++hh) ((LAS float*)(F.lds + att::A_TAB))[hh * 320 + tid] = inw ? rel_bias[bk * 8 + hh] * LOG2E : -1e30f; }
                __syncthreads(); }
              for (int u = VC; u < BATCH * 32; u += GG) { const int blk = u & 15, kvh = (u >> 4) & 1, b = u >> 5, q0 = blk * 128; const size_t rb = (size_t)b * SEQ; unsigned char* ws = WSP();
                att::swa_band_unit(F.lds, WSB(WS_IN) + (rb + q0) * LDI + C_QA + kvh * 512, LDI, WSB(WS_KA) + (size_t)(b * 2 + kvh) * SEQ * 128, WSB(WS_VA) + (size_t)(b * 2 + kvh) * SEQ * 128,
                                   WSB(WS_XN) + (rb + q0) * DM + kvh * 512, DM, q0, kvh * 4, INP(8) + LQ * 8, INP(6) + LQ * 128, (const LAS float*)(F.lds + att::A_TAB)); } }
            for (int u = VC; u < BATCH * 16; u += GG) { const int pr = u & 3, h = (u >> 2) & 3, b = u >> 4; const size_t rb = (size_t)b * SEQ;
                for (int ps = 0; ps < 2; ++ps) { const int q0 = (ps == 0 ? 7 - pr : pr) * 256;
                    unsigned char* ws = WSP(); const bf16_t* QC = WSB(WS_QC); const bf16_t* KVC = WSB(WS_KVC); const bf16_t* KR = WSB(WS_KR); bf16_t* OCAT = WSB(WS_XN); const float* qg = INP(13) + LQ * 192; const GAS f32x4* ROPE = (const GAS f32x4*)(ws + WS_ROPE);
                    att::attn_unit<2>(F.lds, QC + (rb + q0) * 768 + h * 192, 768, KVC + (size_t)(b * 4 + h) * SEQ * 128, 128, KR + rb * 64, KVC + 16 * MiB + (size_t)(b * 4 + h) * SEQ * 128, 128,
                                      OCAT + (rb + q0) * DM + 1536 + h * 128, DM, q0, 0.f, qg, (const f32x4*)(ROPE + (rb + q0) * 16)); } }
        }
        SEAM(P + 5);
        if (PHON(6) && IN(P + 6)) { PHASE_PROLOG(l)
            unsigned char* ws = WSP();
            pg8::SchedBranch S; S.init(WSB(WS_XN), WSB(WS_WL + WL_BR), GG, BX);
            pg8::EpiBranch E{WSB(WS_IN) + C_G, (bf16_t*)OUTP()};
            pg8::gemm_phase<pg8::EpiBranch, pg8::SchedBranch, true, true>(F.lds, DM, DM, S, E);
        }
        SEAM(P + 6);
        if (PHON(7) && IN(P + 7)) { PHASE_PROLOG(l)
            unsigned char* ws = WSP();
            pg8::SchedSimple S; S.init((const bf16_t*)OUTP(), DM, WSB(WS_WL + WL_OUT), DM, M, DM, DM, GG, BX);
            pg8::EpiResX E{(f16_t*)(ws + WS_X16), (float*)(ws + WS_SS)};
            pg8::gemm_phase<pg8::EpiResX, pg8::SchedSimple, false, true>(F.lds, DM, DM, S, E);
        }
        SEAM(P + 7);
        if (PHON(9) && IN(P + 9)) { PHASE_PROLOG(l)
            unsigned char* ws = WSP();
            pg8::SchedSimple S; S.init(WSB(WS_X16), DM, WSB(WS_WL + WL_XQ), DM, M, 512, DM, GG, BX);
            pg8::EpiStore E{WSB(WS_XQ), 512, 0, 0, (const float*)(ws + WS_SS)};
            pg8::gemm_phase<pg8::EpiStore, pg8::SchedSimple, true, true, true>(F.lds, DM, DM, S, E);
        }
        SEAM(P + 9);
        if (PHON(10) && IN(P + 10)) { PHASE_PROLOG(l)
            unsigned char* ws = WSP(); const bf16_t* XQ = WSB(WS_XQ); bf16_t* XO = WSB(WS_XO); const float* g = INP(21) + LQ * 128;
            const bf16_t* XKVl = WSB(WS_XKV) + (size_t)LQ * MMEM * 1024;
            for (int u = VC; u < BATCH * 32; u += GG) { const int i = u & 7, h = (u >> 3) & 3, b = u >> 5, q0 = i * 256; const size_t rb = (size_t)b * SEQ;
                const bf16_t* Kb = XKVl + (size_t)((b * 4 + h) * 2) * 256 * 128;
                att::attn_unit<3>(F.lds, XQ + (rb + q0) * 512 + h * 128, 512, Kb, 128, nullptr, Kb + 256 * 128, 128, XO + (rb + q0) * 512 + h * 128, 512, q0, 0.f, g, nullptr); }
        }
        SEAM(P + 10);
        if (PHON(11) && IN(P + 11)) { PHASE_PROLOG(l)
            unsigned char* ws = WSP();
            pg8::SchedSimple S; S.init(WSB(WS_XO), 512, WSB(WS_WL + WL_XO), 512, M, DM, 512, GG, BX);
            pg8::EpiResX E{(f16_t*)(ws + WS_X16), (float*)(ws + WS_SS)};
            pg8::gemm_phase<pg8::EpiResX, pg8::SchedSimple, false, true>(F.lds, 512, 512, S, E);
        }
        SEAM(P + 11);
        if (PHON(12) && IN(P + 12)) { PHASE_PROLOG(l) unsigned char* ws = WSP(); reduce_ss((const float*)(ws + WS_SS), (float*)(ws + WS_RS), GW * 64 + LN, NGW * 64); }
        SEAM(P + 12);
        if (PHON(13) && IN(P + 13)) { PHASE_PROLOG(l)
            unsigned char* ws = WSP();
            pg8::SchedSimple S; S.init(WSB(WS_X16), DM, WSB(WS_WL + WL_GU), DM, M, 2 * DFF, DM, GG, BX);
            pg8::EpiSwiglu E{WSB(WS_IN), (const float*)(ws + WS_RS)};
            pg8::gemm_phase<pg8::EpiSwiglu, pg8::SchedSimple, true, true, true>(F.lds, DM, DM, S, E);
        }
        SEAM(P + 13);
        if (PHON(14) && IN(P + 14)) { PHASE_PROLOG(l)
            unsigned char* ws = WSP();
            pg8::SchedSimple S; S.init(WSB(WS_IN), DFF, WSB(WS_WL + WL_DN), DFF, M, DM, DFF, GG, BX);
            if (LQ == DEPTH - 1) { pg8::EpiResF E{(const f16_t*)(ws + WS_X16), OUTP()}; pg8::gemm_phase<pg8::EpiResF, pg8::SchedSimple, false, true>(F.lds, DFF, DFF, S, E); }
            else { pg8::EpiResX E{(f16_t*)(ws + WS_X16), (float*)(ws + WS_SS)}; pg8::gemm_phase<pg8::EpiResX, pg8::SchedSimple, false, true>(F.lds, DFF, DFF, S, E); }
        }
        SEAM(P + 14);
    }
#undef IN
#undef SEAM
#undef WSB
}

extern "C" void kernel_launch(void* const* d_in, const int* in_sizes, int n_in, void* d_out, int out_size, void* d_ws, size_t ws_size, hipStream_t stream) {
    static int grid = 0;
    if (grid == 0) {
        if (n_in != 27 || out_size != M * DM || ws_size < WS_END) { fprintf(stderr, "kernel_launch: unexpected shapes: n_in %d out %d ws %zu (need %zu)\n", n_in, out_size, ws_size, (size_t)WS_END); grid = -1; return; }
        int dev = 0, cus = 0;
        if (hipGetDevice(&dev) != hipSuccess || hipDeviceGetAttribute(&cus, hipDeviceAttributeMultiprocessorCount, dev) != hipSuccess) { grid = -1; return; }
        if (hipFuncSetAttribute((const void*)trunk_fwd, hipFuncAttributeMaxDynamicSharedMemorySize, LDS_BYTES) != hipSuccess) { fprintf(stderr, "kernel_launch: hipFuncSetAttribute failed\n"); grid = -1; return; }
        int per_cu = 0;
        if (hipOccupancyMaxActiveBlocksPerMultiprocessor(&per_cu, (const void*)trunk_fwd, NWAVES * 64, LDS_BYTES) != hipSuccess || per_cu < 1) fprintf(stderr, "kernel_launch: occupancy query says %d\n", per_cu);
        (void)hipGetLastError();
        grid = cus;
    }
    if (grid < 0) return;
    (void)hipMemsetAsync((char*)d_ws + WS_CTL, 0, CTL_ZERO_BYTES, stream);
    Args a{};
    for (int i = 0; i < 27; ++i) a.in[i] = (const float*)d_in[i];
    a.pos = (const int*)d_in[2]; a.out = (float*)d_out; a.ws = (unsigned char*)d_ws;
#if MK_ONE_LAUNCH
    a.ph_lo = 0; a.ph_hi = NPHASE;
    hipLaunchKernelGGL(trunk_fwd, dim3(grid), dim3(NWAVES * 64), LDS_BYTES, stream, a);
#else
    for (int p = 0; p < NPHASE; ++p) { a.ph_lo = p; a.ph_hi = p + 1; hipLaunchKernelGGL(trunk_fwd, dim3(grid), dim3(NWAVES * 64), LDS_BYTES, stream, a); }
#endif
    if (PROBE_SET) {
        for (int l = 0; l < DEPTH; ++l) for (int k = 0; k < NP; ++k) if ((PROBE_SET >> k) & 1ull) {
            Args b = a; b.ph_lo = NPRE + l * NP + k; b.ph_hi = b.ph_lo + 1;
            if (k == 7) b.out = (float*)((unsigned char*)d_ws + WS_IN); if (k == 11 || k == 14 || k == 8 || k == 12) b.out = (float*)((unsigned char*)d_ws + WS_XN);
            hipLaunchKernelGGL(trunk_fwd, dim3(grid), dim3(NWAVES * 64), LDS_BYTES, stream, b); }
    }
    const hipError_t le = hipPeekAtLastError();
    if (le != hipSuccess) fprintf(stderr, "kernel_launch: launch failed: %s\n", hipGetErrorName(le));
}
```

```cpp
#include <hip/hip_runtime.h>
#include <cstdio>
#include <cstdint>

#ifndef PHASE_MASK
#define PHASE_MASK 0xFFFFFFFFull
#endif
#define PHON(k) (((PHASE_MASK) >> (k)) & 1ull)
#ifndef ATT_MFMA
#define ATT_MFMA 0xF
#endif
#ifndef PROBE_SET
#define PROBE_SET 0ull
#endif
#ifndef MK_ONE_LAUNCH
#define MK_ONE_LAUNCH 1
#endif

#define GAS __attribute__((address_space(1)))
#define LAS __attribute__((address_space(3)))
typedef unsigned short bf16_t;
typedef short bf16x8 __attribute__((ext_vector_type(8)));
typedef _Float16 f16_t;
typedef _Float16 f16x8 __attribute__((ext_vector_type(8)));
typedef short s16x4 __attribute__((ext_vector_type(4)));
typedef float f32x2 __attribute__((ext_vector_type(2)));
typedef float f32x4 __attribute__((ext_vector_type(4)));
typedef float f32x16 __attribute__((ext_vector_type(16)));
typedef unsigned u32x2 __attribute__((ext_vector_type(2)));
typedef unsigned u32x4 __attribute__((ext_vector_type(4)));
typedef GAS unsigned gu32;

constexpr int BATCH = 16, SEQ = 2048, DM = 2048, M = BATCH * SEQ, DEPTH = 4;
constexpr int MEMLEN = 256, MMEM = BATCH * MEMLEN;
constexpr int IN_W = 10304, LDI = 10496;
constexpr int DFF = 5632;
constexpr float EPS = 1e-6f;
constexpr float LOG2E = 1.4426950408889634f;
constexpr int C_QA = 0, C_KA = 1024, C_VA = 1280, C_QB = 1536, C_KB = 2048, C_VB = 2560, C_CQ = 3072, C_CKV = 3584, C_G = 4096, C_KR = 10240;
constexpr int NP = 15;
constexpr int NPRE = 3;
constexpr int NPHASE = NPRE + DEPTH * NP;

constexpr size_t MiB = 1u << 20;
constexpr size_t WS_CTL = 0, CTL_ZERO_BYTES = 1 * MiB;
constexpr size_t WS_TAB = 1 * MiB;
constexpr size_t WS_WL = 2 * MiB;
constexpr size_t WL_IN = 0, WL_GU = 41 * MiB, WL_DN = 85 * MiB, WL_BR = 107 * MiB, WL_OUT = 115 * MiB, WL_XQ = 123 * MiB, WL_XO = 125 * MiB, WL_UKV = 127 * MiB, WL_UQ = 128 * MiB;
constexpr size_t WS_WXKV = 132 * MiB;
constexpr size_t WS_IN = 148 * MiB;
constexpr size_t WS_XN = 804 * MiB;
constexpr size_t WS_X16 = 932 * MiB;
constexpr size_t WS_QC = 1060 * MiB;
constexpr size_t WS_KVC = 1108 * MiB;
constexpr size_t WS_KR = 1172 * MiB;
constexpr size_t WS_MEMN = 1176 * MiB;
constexpr size_t WS_XKV = 1192 * MiB;
constexpr size_t WS_XQ = WS_IN + 416 * MiB;
constexpr size_t WS_KA = 1224 * MiB, WS_VA = 1240 * MiB;
constexpr size_t WS_XO = 1256 * MiB;
constexpr size_t WS_ROPE = 1288 * MiB;
constexpr size_t WS_SS = 1296 * MiB;
constexpr size_t WS_KR2 = 1300 * MiB;
constexpr size_t WS_KB = 1316 * MiB, WS_VB = 1348 * MiB;
constexpr size_t WS_RS = 1380 * MiB;
constexpr size_t WS_END = 1381 * MiB;
static_assert(WS_IN + (size_t)M * LDI * 2 <= WS_XN && WL_UQ + 768 * 512 * 2 <= 130 * MiB, "ws map");

constexpr int RING_BYTES = 131072;
constexpr int LDSCTL_OFF = RING_BYTES, MISC_OFF = LDSCTL_OFF + 320, PT_OFF = LDSCTL_OFF + 1024;
constexpr int RS_LDS_OFF = LDSCTL_OFF + 10240;
constexpr int LDS_BYTES = 147456;
constexpr int NWAVES = 8;

#define RLX_AGENT __ATOMIC_RELAXED, __HIP_MEMORY_SCOPE_AGENT
#define LDS_WAIT() asm volatile("s_waitcnt lgkmcnt(0)" ::: "memory")
#define VM_WAIT() asm volatile("s_waitcnt vmcnt(0)" ::: "memory")
__device__ __forceinline__ unsigned cvt_pk_bf16(float lo, float hi) { unsigned r; asm volatile("v_cvt_pk_bf16_f32 %0, %1, %2" : "=v"(r) : "v"(lo), "v"(hi)); return r; }
__device__ __forceinline__ float bf2f(short h) { return __builtin_bit_cast(float, ((unsigned)(unsigned short)h) << 16); }
__device__ __forceinline__ float wave_sum(float v) {
#pragma unroll
    for (int o = 1; o < 64; o <<= 1) v += __shfl_xor(v, o);
    return v;
}
__device__ __forceinline__ float wave_max(float v) {
#pragma unroll
    for (int o = 1; o < 64; o <<= 1) v = fmaxf(v, __shfl_xor(v, o));
    return v;
}
__device__ __forceinline__ float fast_exp2(float x) { return __builtin_amdgcn_exp2f(x); }
__device__ __forceinline__ float fast_rcp(float x) { return __builtin_amdgcn_rcpf(x); }
__device__ __forceinline__ float sigmoidf_(float z) { return fast_rcp(1.f + fast_exp2(-z * LOG2E)); }
__device__ __forceinline__ u32x4 pack8(const float* v) { u32x4 w; w.x = cvt_pk_bf16(v[0], v[1]); w.y = cvt_pk_bf16(v[2], v[3]); w.z = cvt_pk_bf16(v[4], v[5]); w.w = cvt_pk_bf16(v[6], v[7]); return w; }

namespace pg8 {
constexpr int BM = 256, BK = 64, HALF = 128, HTB = HALF * BK * 2, NXCD = 8, WGM = 4;
__host__ __device__ __forceinline__ int lds_byte(int r, int c) { const int st = (r >> 4) * 2 + (c >> 5), rr = r & 15, cc = c & 31, ob = rr * 64 + cc * 2; return st * 1024 + (ob ^ (((ob >> 9) & 1) << 5)); }
__host__ __device__ __forceinline__ void stage_rc(int b, int& R, int& C) { const int st = b / 1024, sb = b % 1024, swz = sb ^ (((sb >> 9) & 1) << 5); R = (st >> 1) * 16 + swz / 64; C = (st & 1) * 32 + (swz % 64) / 2; }
__host__ __device__ __forceinline__ int perm32(int rho) { const int n = rho >> 4, i = rho & 15; return 8 * (i >> 2) + 4 * n + (i & 3); }

struct GUnit { const char* A; const char* B; int nt; int pm, pn, seg; };

struct TileOrder {
    int nM, nN, nwg, G, c;
    __device__ void init(int nM_, int nN_, int G_, int c_) { nM = nM_; nN = nN_; nwg = nM * nN; G = G_; c = c_; }
    __device__ bool tile(int i, int& pm, int& pn) const {
        const long L = (long)i * G + c; if (L >= nwg) return false;
        int wgid = (int)L; { const int q = nwg / NXCD, r = nwg % NXCD, xcd = wgid % NXCD, off = wgid / NXCD; wgid = (xcd < r ? xcd * (q + 1) : r * (q + 1) + (xcd - r) * q) + off; }
        const int nig = WGM * nN, gid = wgid / nig, fm = gid * WGM, gsz = (nM - fm) < WGM ? (nM - fm) : WGM;
        pm = fm + ((wgid % nig) % gsz); pn = (wgid % nig) / gsz; return true;
    }
};
struct SchedSimple {
    TileOrder T; const char* A; const char* B; size_t tA, tB; int nt;
    __device__ void init(const bf16_t* A_, int lda, const bf16_t* B_, int ldb, int Mr, int N, int K, int G, int c) { T.init(Mr / BM, N / BM, G, c); A = (const char*)A_; B = (const char*)B_; tA = (size_t)BM * lda * 2; tB = (size_t)BM * ldb * 2; nt = K / BK; }
    __device__ bool next(int i, GUnit& u) const { int pm, pn; if (!T.tile(i, pm, pn)) return false; u.A = A + pm * tA; u.B = B + pn * tB; u.nt = nt; u.pm = pm; u.pn = pn; u.seg = 0; return true; }
};
struct SchedIn {
    TileOrder T; const char* A; const char* B; size_t tA, tB;
    __device__ void init(const bf16_t* A_, const bf16_t* B_, int G, int c) { T.init(M / BM, 40, G, c); A = (const char*)A_; B = (const char*)B_; tA = (size_t)BM * DM * 2; tB = (size_t)BM * DM * 2; }
    __device__ bool next(int i, GUnit& u) const { int pm, pn;
        if (T.tile(i, pm, pn)) { u.A = A + pm * tA; u.B = B + pn * tB; u.nt = 32; u.pm = pm; u.pn = pn; u.seg = 0; return true; }
        const long hu = (long)i * T.G + T.c - T.nwg; if (hu < 0 || hu >= 256) return false;
        const int kh = (int)hu & 1; pm = (int)hu >> 1; u.A = A + pm * tA + kh * 2048; u.B = B + 40 * tB + kh * 2048; u.nt = 16; u.pm = pm; u.pn = 40 + kh; u.seg = 0; return true; }
};
struct SchedBranch {
    TileOrder T; const char* A; const char* B; size_t tA, tB;
    __device__ void init(const bf16_t* A_, const bf16_t* B_, int G, int c) { T.init(M / BM, DM / BM, G, c); A = (const char*)A_; B = (const char*)B_; tA = (size_t)BM * DM * 2; tB = (size_t)BM * DM * 2; }
    __device__ bool next(int i, GUnit& u) const { int pm, pn; const int ti = i / 3, seg = i - 3 * ti; if (!T.tile(ti, pm, pn)) return false;
        const int koff = seg == 0 ? 0 : (seg == 1 ? 1024 : 1536); u.A = A + pm * tA + koff * 2; u.B = B + pn * tB + koff * 2; u.nt = seg == 0 ? 16 : 8; u.pm = pm; u.pn = pn; u.seg = seg; return true; }
};

__device__ __forceinline__ void row_scales(const float* SS, int row0, int fq, float (&rs)[2][4]) {
    f32x4 pa_[2][4], pb_[2][4];
#pragma unroll
    for (int ai = 0; ai < 2; ++ai)
#pragma unroll
        for (int m = 0; m < 4; ++m) { const float* p = SS + (size_t)(row0 + ai * HALF + m * 16) * 32 + fq * 8; pa_[ai][m] = *(const GAS f32x4*)p; pb_[ai][m] = *(const GAS f32x4*)(p + 4); }
    __builtin_amdgcn_sched_barrier(0);
#pragma unroll
    for (int ai = 0; ai < 2; ++ai)
#pragma unroll
        for (int m = 0; m < 4; ++m) { const f32x4 a = pa_[ai][m], b = pb_[ai][m];
            float s = (a[0] + a[1]) + (a[2] + a[3]) + (b[0] + b[1]) + (b[2] + b[3]); s += __shfl_xor(s, 16); s += __shfl_xor(s, 32);
            rs[ai][m] = 1.0f / sqrtf(s * (1.f / 2048.f) + EPS); }
}
struct EpiStore {
    bf16_t* O; int ldc; int sig_lo, sig_hi; const float* SS; int hm = 0; const float* RS = nullptr;
    __device__ __forceinline__ bf16_t* hm_dest(int pn, int bj, int row, int c128) const {
        char* ob = (char*)O;
        if (hm == 1) { const int b = row >> 11, s = row & (SEQ - 1);
            if (pn == 4) return (bf16_t*)(ob + (WS_KA - WS_IN)) + ((size_t)(b * 2 + bj) * SEQ + s) * 128 + c128;
            if (pn == 5) return (bf16_t*)(ob + (WS_VA - WS_IN)) + ((size_t)(b * 2 + bj) * SEQ + s) * 128 + c128;
            if (pn == 8 || pn == 9) return (bf16_t*)(ob + (WS_KB - WS_IN)) + ((size_t)(b * 4 + (pn - 8) * 2 + bj) * SEQ + s) * 128 + c128;
            if (pn == 10 || pn == 11) return (bf16_t*)(ob + (WS_VB - WS_IN)) + ((size_t)(b * 4 + (pn - 10) * 2 + bj) * SEQ + s) * 128 + c128;
            return nullptr; }
        if (hm == 2) { const int b = row >> 11, s = row & (SEQ - 1); return (bf16_t*)(ob + (bj == 0 ? 0 : 32 * MiB)) + ((size_t)(b * 4 + pn) * SEQ + s) * 128 + c128; }
        if (hm == 3) { const int l = row >> 12, b = (row >> 8) & 15, s = row & 255; return O + ((size_t)(((l * 16 + b) * 4 + pn) * 2 + bj) * 256 + s) * 128 + c128; }
        return nullptr;
    }
    __device__ __forceinline__ bool operator()(f32x4 (&acc)[2][2][4][2], const GUnit& u, int wr, int wc, int fr, int fq, const float (&prs)[2][4]) const {
        const int row0 = u.pm * BM + wr * 64 + fr, col0 = u.pn * BM + wc * 32 + 8 * fq; const bool sig = u.pn >= sig_lo && u.pn < sig_hi;
        float rs[2][4];
        if (SS) row_scales(SS, row0, fq, rs);
        else if (RS) {
#pragma unroll
            for (int ai = 0; ai < 2; ++ai)
#pragma unroll
                for (int m = 0; m < 4; ++m) rs[ai][m] = prs[ai][m]; }
#pragma unroll
        for (int ai = 0; ai < 2; ++ai)
#pragma unroll
            for (int m = 0; m < 4; ++m) { bf16_t* rowp = (u.pn == 41) ? (bf16_t*)((char*)O + (WS_KR2 - WS_IN)) + (size_t)(row0 + ai * HALF + m * 16) * 256 + wc * 32 + 8 * fq : O + (size_t)(row0 + ai * HALF + m * 16) * ldc + col0;
#pragma unroll
                for (int bj = 0; bj < 2; ++bj) { float v[8];
#pragma unroll
                    for (int j = 0; j < 4; ++j) { v[j] = acc[ai][bj][m][0][j]; v[4 + j] = acc[ai][bj][m][1][j]; }
                    if (SS || RS) {
#pragma unroll
                        for (int j = 0; j < 8; ++j) v[j] *= rs[ai][m]; }
                    if (sig) {
#pragma unroll
                        for (int j = 0; j < 8; ++j) v[j] = fmaxf(sigmoidf_(v[j]), 1e-18f); }
                    bf16_t* hd = hm ? hm_dest(u.pn, bj, row0 + ai * HALF + m * 16, wc * 32 + 8 * fq) : nullptr;
                    if (hd) *(GAS u32x4*)hd = pack8(v); else *(GAS u32x4*)(rowp + bj * HALF) = pack8(v); } }
        return true;
    }
};
struct EpiRes {
    const float* base; float* out;
    __device__ __forceinline__ bool operator()(f32x4 (&acc)[2][2][4][2], const GUnit& u, int wr, int wc, int fr, int fq) const {
        const int row0 = u.pm * BM + wr * 64 + fr, col0 = u.pn * BM + wc * 32 + 8 * fq;
#pragma unroll
        for (int ai = 0; ai < 2; ++ai) { f32x4 bv[4][2][2];
#pragma unroll
            for (int m = 0; m < 4; ++m) { const size_t off = (size_t)(row0 + ai * HALF + m * 16) * DM + col0;
#pragma unroll
                for (int bj = 0; bj < 2; ++bj)
#pragma unroll
                    for (int n = 0; n < 2; ++n) bv[m][bj][n] = *(const GAS f32x4*)(base + off + bj * HALF + 4 * n); }
            __builtin_amdgcn_sched_barrier(0);
#pragma unroll
            for (int m = 0; m < 4; ++m) { const size_t off = (size_t)(row0 + ai * HALF + m * 16) * DM + col0;
#pragma unroll
                for (int bj = 0; bj < 2; ++bj)
#pragma unroll
                    for (int n = 0; n < 2; ++n) *(GAS f32x4*)(out + off + bj * HALF + 4 * n) = bv[m][bj][n] + acc[ai][bj][m][n]; }
            __builtin_amdgcn_sched_barrier(0); }
        return true;
    }
};
struct EpiResX {
    f16_t* X16; float* SS;
    __device__ __forceinline__ bool operator()(f32x4 (&acc)[2][2][4][2], const GUnit& u, int wr, int wc, int fr, int fq) const {
        const int row0 = u.pm * BM + wr * 64 + fr, col0 = u.pn * BM + wc * 32 + 8 * fq;
        f16x8 bv[2][4][2];
#pragma unroll
        for (int ai = 0; ai < 2; ++ai)
#pragma unroll
            for (int m = 0; m < 4; ++m) { const size_t off = (size_t)(row0 + ai * HALF + m * 16) * DM + col0;
#pragma unroll
                for (int bj = 0; bj < 2; ++bj) bv[ai][m][bj] = *(const GAS f16x8*)(X16 + off + bj * HALF); }
        __builtin_amdgcn_sched_barrier(0);
#pragma unroll
        for (int ai = 0; ai < 2; ++ai) {
#pragma unroll
            for (int m = 0; m < 4; ++m) { const int row = row0 + ai * HALF + m * 16; const size_t off = (size_t)row * DM + col0; float s = 0.f;
#pragma unroll
                for (int bj = 0; bj < 2; ++bj) { f16x8 h;
#pragma unroll
                    for (int n = 0; n < 2; ++n)
#pragma unroll
                        for (int j = 0; j < 4; ++j) { const float x = (float)bv[ai][m][bj][4 * n + j] + acc[ai][bj][m][n][j]; h[4 * n + j] = (f16_t)x; s += x * x; }
                    *(GAS f16x8*)(X16 + off + bj * HALF) = h; }
                s += __shfl_xor(s, 16); s += __shfl_xor(s, 32);
                if (fq == 0) ((GAS float*)SS)[(size_t)row * 32 + u.pn * 4 + wc] = s; }
            __builtin_amdgcn_sched_barrier(0); }
        return true;
    }
};
struct EpiResF {
    const f16_t* X16; float* out;
    __device__ __forceinline__ bool operator()(f32x4 (&acc)[2][2][4][2], const GUnit& u, int wr, int wc, int fr, int fq) const {
        const int row0 = u.pm * BM + wr * 64 + fr, col0 = u.pn * BM + wc * 32 + 8 * fq;
#pragma unroll
        for (int ai = 0; ai < 2; ++ai) { f16x8 bv[4][2];
#pragma unroll
            for (int m = 0; m < 4; ++m) { const size_t off = (size_t)(row0 + ai * HALF + m * 16) * DM + col0;
#pragma unroll
                for (int bj = 0; bj < 2; ++bj) bv[m][bj] = *(const GAS f16x8*)(X16 + off + bj * HALF); }
            __builtin_amdgcn_sched_barrier(0);
#pragma unroll
            for (int m = 0; m < 4; ++m) { const size_t off = (size_t)(row0 + ai * HALF + m * 16) * DM + col0;
#pragma unroll
                for (int bj = 0; bj < 2; ++bj)
#pragma unroll
                    for (int n = 0; n < 2; ++n) { f32x4 x;
#pragma unroll
                        for (int j = 0; j < 4; ++j) x[j] = (float)bv[m][bj][4 * n + j] + acc[ai][bj][m][n][j];
                        *(GAS f32x4*)(out + off + bj * HALF + 4 * n) = x; } }
            __builtin_amdgcn_sched_barrier(0); }
        return true;
    }
};
struct EpiUkv {
    bf16_t* O; const float* kg; LAS float* xs; const float* RS;
    __device__ __forceinline__ bool operator()(f32x4 (&acc)[2][2][4][2], const GUnit& u, int wr, int wc, int fr, int fq, const float (&rs)[2][4]) const {
        const int row0 = u.pm * BM + wr * 64 + fr, c128 = wc * 32 + 8 * fq;
#pragma unroll
        for (int ai = 0; ai < 2; ++ai)
#pragma unroll
            for (int m = 0; m < 4; ++m)
#pragma unroll
                for (int bj = 0; bj < 2; ++bj)
#pragma unroll
                    for (int n = 0; n < 2; ++n) acc[ai][bj][m][n] *= rs[ai][m];
#pragma unroll
        for (int ai = 0; ai < 2; ++ai)
#pragma unroll
            for (int m = 0; m < 4; ++m) { float s = 0.f;
#pragma unroll
                for (int n = 0; n < 2; ++n)
#pragma unroll
                    for (int j = 0; j < 4; ++j) { const float x = acc[ai][0][m][n][j]; s += x * x; }
                s += __shfl_xor(s, 16); s += __shfl_xor(s, 32);
                if (fq == 0) xs[(ai * HALF + wr * 64 + m * 16 + fr) * 4 + wc] = s; }
        asm volatile("s_waitcnt lgkmcnt(0)" ::: "memory"); __builtin_amdgcn_s_barrier(); asm volatile("" ::: "memory");
        const f32x4 g0 = *(const GAS f32x4*)(kg + c128), g1 = *(const GAS f32x4*)(kg + c128 + 4);
#pragma unroll
        for (int ai = 0; ai < 2; ++ai)
#pragma unroll
            for (int m = 0; m < 4; ++m) { const f32x4 p = *(const LAS f32x4*)(xs + (ai * HALF + wr * 64 + m * 16 + fr) * 4);
                const float r = 1.0f / sqrtf(((p[0] + p[1]) + (p[2] + p[3])) * (1.f / 128.f) + EPS);
                const int row = row0 + ai * HALF + m * 16, b = row >> 11, s = row & (SEQ - 1);
                bf16_t* kd = O + ((size_t)(b * 4 + u.pn) * SEQ + s) * 128 + c128; float v[8];
#pragma unroll
                for (int j = 0; j < 4; ++j) { v[j] = acc[ai][0][m][0][j] * r * g0[j]; v[4 + j] = acc[ai][0][m][1][j] * r * g1[j]; }
                *(GAS u32x4*)kd = pack8(v);
#pragma unroll
                for (int j = 0; j < 4; ++j) { v[j] = acc[ai][1][m][0][j]; v[4 + j] = acc[ai][1][m][1][j]; }
                *(GAS u32x4*)(kd + 16 * MiB) = pack8(v); }
        asm volatile("s_waitcnt lgkmcnt(0)" ::: "memory"); __builtin_amdgcn_s_barrier(); asm volatile("" ::: "memory");
        return true;
    }
};
struct EpiSwiglu {
    bf16_t* H; const float* RS;
    __device__ __forceinline__ bool operator()(f32x4 (&acc)[2][2][4][2], const GUnit& u, int wr, int wc, int fr, int fq, const float (&rs)[2][4]) const {
        const int row0 = u.pm * BM + wr * 64 + fr, col0 = u.pn * HALF + wc * 32 + 8 * fq;
#pragma unroll
        for (int ai = 0; ai < 2; ++ai)
#pragma unroll
            for (int m = 0; m < 4; ++m) { float v[8]; const float r = rs[ai][m];
#pragma unroll
                for (int n = 0; n < 2; ++n)
#pragma unroll
                    for (int j = 0; j < 4; ++j) { const float g = acc[ai][0][m][n][j] * r, up = acc[ai][1][m][n][j] * r; v[4 * n + j] = g * sigmoidf_(g) * up; }
                *(GAS u32x4*)(H + (size_t)(row0 + ai * HALF + m * 16) * DFF + col0) = pack8(v); }
        return true;
    }
};
struct EpiBranch {
    const bf16_t* G; bf16_t* O;
    __device__ __forceinline__ bool operator()(f32x4 (&acc)[2][2][4][2], const GUnit& u, int wr, int wc, int fr, int fq) const {
        const int row0 = u.pm * BM + wr * 64 + fr, col0 = u.pn * BM + wc * 32 + 8 * fq; const int seg = u.seg;
        const int cn = (seg == 2 ? 2 : seg) * DM, cd = (seg == 2 ? 2 : seg + 1) * DM;
#pragma unroll
        for (int ai = 0; ai < 2; ++ai) { bf16x8 gn[4][2], gd[4][2];
#pragma unroll
            for (int m = 0; m < 4; ++m) { const size_t goff = (size_t)(row0 + ai * HALF + m * 16) * LDI + col0;
#pragma unroll
                for (int bj = 0; bj < 2; ++bj) { gn[m][bj] = *(const GAS bf16x8*)(G + goff + cn + bj * HALF); gd[m][bj] = *(const GAS bf16x8*)(G + goff + cd + bj * HALF); } }
            __builtin_amdgcn_sched_barrier(0);
#pragma unroll
            for (int m = 0; m < 4; ++m)
#pragma unroll
                for (int bj = 0; bj < 2; ++bj) { float f[8];
                    if (seg < 2) {
#pragma unroll
                        for (int j = 0; j < 8; ++j) f[j] = bf2f(gn[m][bj][j]) * fast_rcp(bf2f(gd[m][bj][j])); }
                    else {
#pragma unroll
                        for (int j = 0; j < 8; ++j) f[j] = bf2f(gn[m][bj][j]); }
#pragma unroll
                    for (int j = 0; j < 4; ++j) { acc[ai][bj][m][0][j] *= f[j]; acc[ai][bj][m][1][j] *= f[4 + j]; }
                    if (seg == 2) { float v[8];
#pragma unroll
                        for (int j = 0; j < 4; ++j) { v[j] = acc[ai][bj][m][0][j]; v[4 + j] = acc[ai][bj][m][1][j]; }
                        *(GAS u32x4*)(O + (size_t)(row0 + ai * HALF + m * 16) * DM + col0 + bj * HALF) = pack8(v); } }
            __builtin_amdgcn_sched_barrier(0); }
        return seg == 2;
    }
};

template <class Epi> struct EpiHook {
    __device__ __forceinline__ void prefetch(const Epi&, const GUnit&, int, int, LAS unsigned char*) {}
    __device__ __forceinline__ bool call(const Epi& E, f32x4 (&acc)[2][2][4][2], const GUnit& u, int wr, int wc, int fr, int fq, LAS unsigned char*) { return E(acc, u, wr, wc, fr, fq); }
};
template <class Epi> struct EpiHookRS {
    __device__ __forceinline__ void prefetch(const Epi& E, const GUnit& u, int wr, int lane, LAS unsigned char* wl) {
        if (E.RS) { const float* p = E.RS + u.pm * BM + wr * 64 + lane;
            __builtin_amdgcn_global_load_lds((const unsigned*)p, (LAS unsigned*)wl, 4, 0, 0);
            __builtin_amdgcn_global_load_lds((const unsigned*)(p + HALF), (LAS unsigned*)(wl + 256), 4, 0, 0); }
    }
    __device__ __forceinline__ bool call(const Epi& E, f32x4 (&acc)[2][2][4][2], const GUnit& u, int wr, int wc, int fr, int fq, LAS unsigned char* wl) {
        float rs[2][4];
#pragma unroll
        for (int ai = 0; ai < 2; ++ai)
#pragma unroll
            for (int m = 0; m < 4; ++m) rs[ai][m] = E.RS ? *(const LAS float*)(wl + ai * 256 + (m * 16 + fr) * 4) : 1.f;
        return E(acc, u, wr, wc, fr, fq, rs);
    }
};
template <> struct EpiHook<EpiStore> : EpiHookRS<EpiStore> {};
template <> struct EpiHook<EpiSwiglu> : EpiHookRS<EpiSwiglu> {};
template <> struct EpiHook<EpiUkv> : EpiHookRS<EpiUkv> {};
template <bool F16> __device__ __forceinline__ f32x4 mma16(bf16x8 b, bf16x8 a, f32x4 c) {
    if constexpr (F16) return __builtin_amdgcn_mfma_f32_16x16x32_f16(__builtin_bit_cast(f16x8, b), __builtin_bit_cast(f16x8, a), c, 0, 0, 0);
    else return __builtin_amdgcn_mfma_f32_16x16x32_bf16(b, a, c, 0, 0, 0);
}
template <class Epi, class Sched, bool ALIGN_EPI, bool SP2, bool F16 = false>
__device__ __forceinline__ void gemm_phase(LAS unsigned char* lds, const int lda, const int ldb, const Sched& S, const Epi& E) {
    int tid = threadIdx.x; asm volatile("" : "+v"(tid));
    const int wid = __builtin_amdgcn_readfirstlane(tid >> 6), lane = tid & 63, wr = wid >> 2, wc = wid & 3, fr = lane & 15, fq = lane >> 4;
    unsigned voffA[2], voffB[2];
#pragma unroll
    for (int i = 0; i < 2; ++i) { int R, C; stage_rc(tid * 16 + i * 8192, R, C); const int Rb = (R & ~31) + perm32(R & 31);
        voffA[i] = (unsigned)(R * lda + C) * 2u; voffB[i] = (unsigned)(Rb * ldb + C) * 2u; }
    const size_t kstep = (size_t)(BK * 2);
    const size_t hstepA = (size_t)HALF * lda * 2, hstepB = (size_t)HALF * ldb * 2;
    const unsigned ldsw = (unsigned)wid * 1024u;
    const int aoff = lds_byte(wr * 64 + fr, fq * 8), boff = lds_byte(wc * 32 + fr, fq * 8);
#define PG8_SA(b, h) (((b) * 2 + (h)) * HTB)
#define PG8_SB(b, h) ((4 + (b) * 2 + (h)) * HTB)
    const unsigned ldsb = (unsigned)(unsigned long long)lds + ldsw;
#define PG8_STAGE(bufoff, gbase, voff) do { _Pragma("unroll") for (int _i = 0; _i < 2; ++_i) \
        asm volatile("s_mov_b32 m0, %2\n\ts_nop 0\n\tglobal_load_lds_dwordx4 %0, %1" :: "v"((voff)[_i]), "s"((const char*)(gbase)), "s"(ldsb + (unsigned)((bufoff) + _i * 8192)) : "memory"); } while (0)
#define PG8_LDA(dst, b, h) do { _Pragma("unroll") for (int m = 0; m < 4; ++m) _Pragma("unroll") for (int k = 0; k < 2; ++k) dst[m][k] = *(const LAS bf16x8*)(lds + PG8_SA(b, h) + aoff + m * 2048 + k * 1024); } while (0)
#define PG8_LDB(dst, b, h) do { _Pragma("unroll") for (int n = 0; n < 2; ++n) _Pragma("unroll") for (int k = 0; k < 2; ++k) dst[n][k] = *(const LAS bf16x8*)(lds + PG8_SB(b, h) + boff + n * 2048 + k * 1024); } while (0)
#define PG8_MMA(ai, bj, At, Bt) do { __builtin_amdgcn_s_setprio(1); _Pragma("unroll") for (int m = 0; m < 4; ++m) _Pragma("unroll") for (int n = 0; n < 2; ++n) _Pragma("unroll") for (int k = 0; k < 2; ++k) \
        acc[ai][bj][m][n] = mma16<F16>(Bt[n][k], At[m][k], acc[ai][bj][m][n]); __builtin_amdgcn_s_setprio(0); } while (0)
#define PG8_WAIT_V(n) asm volatile("s_waitcnt vmcnt(" #n ")" ::: "memory")
#define PG8_WAIT_L(n) asm volatile("s_waitcnt lgkmcnt(" #n ")" ::: "memory")
#define PG8_BAR __builtin_amdgcn_s_barrier()
#define PG8_SCHED __builtin_amdgcn_sched_barrier(0)
    GUnit cur, nxt; int ui = 0;
    if (!S.next(0, cur)) return;
    EpiHook<Epi> HK; LAS unsigned char* const rswl = lds + RS_LDS_OFF + wid * 512; HK.prefetch(E, cur, wr, lane, rswl);
    f32x4 acc[2][2][4][2];
#pragma unroll
    for (int a = 0; a < 2; ++a)
#pragma unroll
        for (int b = 0; b < 2; ++b)
#pragma unroll
            for (int m = 0; m < 4; ++m)
#pragma unroll
                for (int n = 0; n < 2; ++n) acc[a][b][m][n] = (f32x4){0.f, 0.f, 0.f, 0.f};
    bf16x8 At[4][2], B0[2][2], B1[2][2];
    const char* cA = cur.A; const char* cB = cur.B;
    if constexpr (SP2) {
        PG8_STAGE(PG8_SB(0, 0), cB, voffB); PG8_STAGE(PG8_SB(0, 1), cB + hstepB, voffB); PG8_STAGE(PG8_SA(0, 0), cA, voffA); PG8_STAGE(PG8_SA(0, 1), cA + hstepA, voffA);
        if (wr == 1) PG8_BAR;
        PG8_WAIT_V(2); PG8_BAR;
        PG8_STAGE(PG8_SB(1, 0), cB + kstep, voffB); PG8_STAGE(PG8_SA(1, 0), cA + kstep, voffA); PG8_STAGE(PG8_SB(1, 1), cB + hstepB + kstep, voffB);
        PG8_WAIT_V(6); PG8_BAR;
    } else {
        PG8_STAGE(PG8_SB(0, 0), cB, voffB); PG8_STAGE(PG8_SA(0, 0), cA, voffA); PG8_STAGE(PG8_SB(0, 1), cB + hstepB, voffB); PG8_STAGE(PG8_SA(0, 1), cA + hstepA, voffA);
        if (wr == 1) PG8_BAR;
        PG8_WAIT_V(4); PG8_BAR;
        PG8_STAGE(PG8_SB(1, 0), cB + kstep, voffB); PG8_STAGE(PG8_SA(1, 0), cA + kstep, voffA); PG8_STAGE(PG8_SB(1, 1), cB + hstepB + kstep, voffB);
        PG8_WAIT_V(6); PG8_BAR;
    }
    for (;;) {
        const bool has_next = S.next(ui + 1, nxt);
        const char* nA = has_next ? nxt.A : cA; const char* nB = has_next ? nxt.B : cB;
        const int nt = cur.nt;
        for (int t = 0; t < nt; t += 2) {
            const bool last = (t == nt - 2);
            const char* a1 = cA + (size_t)(t + 1) * kstep;
            const char* a2 = last ? nA : cA + (size_t)(t + 2) * kstep; const char* b2 = last ? nB : cB + (size_t)(t + 2) * kstep;
            const char* a3 = a2 + kstep; const char* b3 = b2 + kstep;
            if constexpr (SP2) {
            PG8_LDB(B0, 0, 0); PG8_LDB(B1, 0, 1); PG8_SCHED; PG8_LDA(At, 0, 0); PG8_STAGE(PG8_SA(1, 1), a1 + hstepA, voffA);
            PG8_WAIT_V(8); PG8_WAIT_L(0); PG8_BAR; PG8_MMA(0, 0, At, B0); PG8_MMA(0, 1, At, B1); PG8_BAR; PG8_SCHED;
            PG8_LDA(At, 0, 1); PG8_STAGE(PG8_SB(0, 0), b2, voffB); PG8_STAGE(PG8_SB(0, 1), b2 + hstepB, voffB); PG8_STAGE(PG8_SA(0, 0), a2, voffA);
            PG8_WAIT_V(8); PG8_WAIT_L(0); PG8_BAR; PG8_MMA(1, 0, At, B0); PG8_MMA(1, 1, At, B1); PG8_BAR; PG8_SCHED;
            PG8_LDB(B0, 1, 0); PG8_LDB(B1, 1, 1); PG8_SCHED; PG8_LDA(At, 1, 0); PG8_STAGE(PG8_SA(0, 1), a2 + hstepA, voffA);
            PG8_WAIT_V(8); PG8_WAIT_L(0); PG8_BAR; PG8_MMA(0, 0, At, B0); PG8_MMA(0, 1, At, B1); PG8_BAR; PG8_SCHED;
            PG8_LDA(At, 1, 1); PG8_STAGE(PG8_SB(1, 0), b3, voffB); PG8_STAGE(PG8_SB(1, 1), b3 + hstepB, voffB); PG8_STAGE(PG8_SA(1, 0), a3, voffA);
            PG8_WAIT_V(8); PG8_WAIT_L(0); PG8_BAR; PG8_MMA(1, 0, At, B0); PG8_MMA(1, 1, At, B1); PG8_BAR; PG8_SCHED;
            } else {
            PG8_LDB(B0, 0, 0); PG8_SCHED; PG8_LDA(At, 0, 0); PG8_STAGE(PG8_SA(1, 1), a1 + hstepA, voffA);
            PG8_WAIT_L(8); PG8_BAR; PG8_WAIT_L(0); PG8_MMA(0, 0, At, B0); PG8_BAR; PG8_SCHED;
            PG8_LDB(B1, 0, 1); PG8_STAGE(PG8_SB(0, 0), b2, voffB);
            PG8_BAR; PG8_WAIT_L(0); PG8_MMA(0, 1, At, B1); PG8_BAR;
            PG8_LDA(At, 0, 1); PG8_STAGE(PG8_SA(0, 0), a2, voffA);
            PG8_BAR; PG8_WAIT_L(0); PG8_MMA(1, 0, At, B0); PG8_BAR; PG8_SCHED;
            PG8_STAGE(PG8_SB(0, 1), b2 + hstepB, voffB);
            PG8_WAIT_V(6); PG8_BAR; PG8_MMA(1, 1, At, B1); PG8_BAR;
            PG8_LDB(B0, 1, 0); PG8_SCHED; PG8_LDA(At, 1, 0); PG8_STAGE(PG8_SA(0, 1), a2 + hstepA, voffA);
            PG8_WAIT_L(8); PG8_BAR; PG8_WAIT_L(0); PG8_MMA(0, 0, At, B0); PG8_BAR; PG8_SCHED;
            PG8_LDB(B1, 1, 1); PG8_STAGE(PG8_SB(1, 0), b3, voffB);
            PG8_BAR; PG8_WAIT_L(0); PG8_MMA(0, 1, At, B1); PG8_BAR;
            PG8_LDA(At, 1, 1); PG8_STAGE(PG8_SA(1, 0), a3, voffA);
            PG8_BAR; PG8_WAIT_L(0); PG8_MMA(1, 0, At, B0); PG8_BAR; PG8_SCHED;
            PG8_STAGE(PG8_SB(1, 1), b3 + hstepB, voffB);
            PG8_WAIT_V(6); PG8_BAR; PG8_MMA(1, 1, At, B1); PG8_BAR;
            }
        }
        if constexpr (ALIGN_EPI) { if (wr == 0) PG8_BAR; }
        const bool zero = HK.call(E, acc, cur, wr, wc, fr, fq, rswl);
        if (!has_next) break;
        if (zero) {
#pragma unroll
        for (int a = 0; a < 2; ++a)
#pragma unroll
            for (int b = 0; b < 2; ++b)
#pragma unroll
                for (int m = 0; m < 4; ++m)
#pragma unroll
                    for (int n = 0; n < 2; ++n) acc[a][b][m][n] = (f32x4){0.f, 0.f, 0.f, 0.f};
        }
        cur = nxt; cA = nA; cB = nB; ++ui; HK.prefetch(E, cur, wr, lane, rswl);
        if constexpr (ALIGN_EPI) { if (wr == 1) PG8_BAR; }
    }
    PG8_WAIT_V(0);
    if constexpr (!ALIGN_EPI) { if (wr == 0) PG8_BAR; }
    PG8_BAR;
#undef PG8_SA
#undef PG8_SB
#undef PG8_STAGE
#undef PG8_LDA
#undef PG8_LDB
#undef PG8_MMA
#undef PG8_WAIT_V
#undef PG8_WAIT_L
#undef PG8_BAR
#undef PG8_SCHED
}
}

#define XB_TMO      128
#define XB_XCNT(j)  (256  + 64 * (j))
#define XB_XSUB(j)  (1280 + 64 * (j))
#define XB_XGEN(j)  (2304 + 64 * (j))
#define XB_TOP      3328
#define XB_TOPGEN   3392
#define XCD_BAR_WORDS 3456
#define XB_SPIN_CAP (1u << 18)
__device__ __forceinline__ unsigned xb_ld(unsigned* p)              { return __hip_atomic_load(p, __ATOMIC_RELAXED, __HIP_MEMORY_SCOPE_AGENT); }
__device__ __forceinline__ unsigned xb_add(unsigned* p, unsigned v) { return __hip_atomic_fetch_add(p, v, __ATOMIC_RELAXED, __HIP_MEMORY_SCOPE_AGENT); }
__device__ __forceinline__ unsigned xb_xcc_id() { return (unsigned)__builtin_amdgcn_s_getreg((3 << 11) | 20) & 0xFu; }
#define XB_SPIN(cond, bar) do { unsigned _sp = 0; while (cond) { __builtin_amdgcn_s_sleep(1); \
    if ((++_sp & 255u) == 0u) { if (xb_ld(&(bar)[XB_TMO])) break; if (_sp > XB_SPIN_CAP) { atomicAdd(&(bar)[XB_TMO], 1u); break; } } } } while (0)
struct XcdBarrier { unsigned* bar; unsigned x; volatile LAS unsigned* st; };
__device__ __forceinline__ XcdBarrier xcd_barrier_post(unsigned* bar, volatile LAS unsigned* st) {
    XcdBarrier b; b.bar = bar; b.x = xb_xcc_id(); b.st = st;
    if (threadIdx.x == 0) (void)xb_add(&bar[XB_XCNT(b.x)], 1u);
    return b;
}
__device__ __forceinline__ void xcd_barrier_complete(unsigned* bar, unsigned x, unsigned& nloc, unsigned& nx) {
    const unsigned G = gridDim.x * gridDim.y * gridDim.z;
    unsigned sum, cnt, mine, sp = 0u;
    for (;;) {
        sum = 0u; cnt = 0u; mine = 0u;
#pragma unroll
        for (unsigned j = 0; j < 16; ++j) { const unsigned c = xb_ld(&bar[XB_XCNT(j)]); sum += c; cnt += (c > 0u) ? 1u : 0u; mine = (j == x) ? c : mine; }
        if (sum == G) break;
        __builtin_amdgcn_s_sleep(1);
        if ((++sp & 255u) == 0u) { if (xb_ld(&bar[XB_TMO])) break; if (sp > XB_SPIN_CAP) { atomicAdd(&bar[XB_TMO], 1u); break; } }
    }
    nloc = mine > 0u ? mine : 1u; nx = cnt > 0u ? cnt : 1u;
}
__device__ __forceinline__ void xcd_barrier(const XcdBarrier& b) {
    asm volatile("s_waitcnt vmcnt(0)" ::: "memory");
    __syncthreads();
    if (threadIdx.x == 0) {
        unsigned* bar = b.bar;
        __builtin_amdgcn_s_waitcnt(0);
        unsigned nloc = b.st[0], nx = b.st[1];
        if (nloc == 0u) { xcd_barrier_complete(bar, b.x, nloc, nx); b.st[0] = nloc; b.st[1] = nx; }
        const unsigned old = xb_add(&bar[XB_XSUB(b.x)], 1u);
        const unsigned gen = old / nloc;
        if (old + 1u == (gen + 1u) * nloc) {
            __builtin_amdgcn_fence(__ATOMIC_RELEASE, "agent");
            asm volatile("s_waitcnt vmcnt(0)" ::: "memory");
            const unsigned og = xb_add(&bar[XB_TOP], 1u);
            const unsigned tg = og / nx;
            if (og + 1u == (tg + 1u) * nx) xb_add(&bar[XB_TOPGEN], 1u);
            else XB_SPIN(xb_ld(&bar[XB_TOPGEN]) == tg, bar);
            __builtin_amdgcn_fence(__ATOMIC_ACQUIRE, "agent");
            xb_add(&bar[XB_XGEN(b.x)], 1u);
            asm volatile("s_waitcnt vmcnt(0)" ::: "memory");
        } else {
            XB_SPIN(xb_ld(&bar[XB_XGEN(b.x)]) == gen, bar);
            __builtin_amdgcn_fence(__ATOMIC_ACQUIRE, "agent");
            asm volatile("s_waitcnt vmcnt(0)" ::: "memory");
        }
    }
    __syncthreads();
}
constexpr int CW_BAR = 4096;

struct Args { const float* in[27]; const int* pos; float* out; unsigned char* ws; int ph_lo, ph_hi; };

struct Frame {
    LAS unsigned char* lds; int tid, lane, wave, G, gw, NGW;
};

__device__ __forceinline__ int map_src_col(int maptype, int n0) {
    if (maptype == 0) return n0;
    if (maptype == 1) { if (n0 < 4096) return n0; if (n0 < 10240) return n0 + 64; if (n0 < 10304) return n0 - 6144; return -1; }
    const int pn = n0 >> 8, r = n0 & 255; return r < 128 ? 128 * pn + r : DFF + 128 * pn + (r - 128);
}
__device__ __forceinline__ void transpose_item(const float* W, int K, int Nsrc, bf16_t* WT, int nblk, const float* gain, int maptype, LAS float* scr, int item, int lane) {
    const int kb = item / nblk, nb = item % nblk, k0 = 64 * kb, n0 = 32 * nb;
    const bool f16o = (maptype & 4) != 0; maptype &= 3;
    const int sc0 = map_src_col(maptype, n0);
    float v[32];
    if (sc0 >= 0) { const GAS float* src = (const GAS float*)W + (size_t)(k0 + (lane >> 5)) * Nsrc + sc0 + (lane & 31);
#pragma unroll
        for (int i = 0; i < 32; ++i) v[i] = src[(size_t)(2 * i) * Nsrc]; }
    else {
#pragma unroll
        for (int i = 0; i < 32; ++i) v[i] = 0.f; }
#pragma unroll
    for (int i = 0; i < 32; ++i) scr[(2 * i + (lane >> 5)) * 33 + (lane & 31)] = v[i];
    LDS_WAIT(); asm volatile("" ::: "memory");
    const int c = lane & 7;
    f32x4 g0 = (f32x4){1.f, 1.f, 1.f, 1.f}, g1 = g0;
    if (gain) { g0 = *(const GAS f32x4*)(gain + k0 + 8 * c); g1 = *(const GAS f32x4*)(gain + k0 + 8 * c + 4); }
#pragma unroll
    for (int j = 0; j < 4; ++j) { const int n = (lane >> 3) + 8 * j; const LAS float* s = scr + (8 * c) * 33 + n;
        if (f16o) { f16x8 h; h[0] = (f16_t)(s[0 * 33] * g0.x); h[1] = (f16_t)(s[1 * 33] * g0.y); h[2] = (f16_t)(s[2 * 33] * g0.z); h[3] = (f16_t)(s[3 * 33] * g0.w);
            h[4] = (f16_t)(s[4 * 33] * g1.x); h[5] = (f16_t)(s[5 * 33] * g1.y); h[6] = (f16_t)(s[6 * 33] * g1.z); h[7] = (f16_t)(s[7 * 33] * g1.w);
            *(GAS f16x8*)(WT + (size_t)(n0 + n) * K + k0 + 8 * c) = h; }
        else {
        u32x4 o; o.x = cvt_pk_bf16(s[0 * 33] * g0.x, s[1 * 33] * g0.y); o.y = cvt_pk_bf16(s[2 * 33] * g0.z, s[3 * 33] * g0.w); o.z = cvt_pk_bf16(s[4 * 33] * g1.x, s[5 * 33] * g1.y); o.w = cvt_pk_bf16(s[6 * 33] * g1.z, s[7 * 33] * g1.w);
        *(GAS u32x4*)(WT + (size_t)(n0 + n) * K + k0 + 8 * c) = o; } }
    LDS_WAIT(); asm volatile("" ::: "memory");
}
struct ConvJob { const float* W; int K, Nsrc; bf16_t* WT; int Nd; const float* gain; int maptype; };
__device__ __forceinline__ int conv_items(const ConvJob& j) { return (j.K / 64) * (j.Nd / 32); }

template <int U> __device__ __forceinline__ void rms_rows(const float* x, bf16_t* o, int r0, int lane) {
    f32x4 v[U][8];
#pragma unroll
    for (int u = 0; u < U; ++u) { const GAS f32x4* xr = (const GAS f32x4*)(x + (size_t)(r0 + u) * DM) + lane;
#pragma unroll
        for (int j = 0; j < 8; ++j) v[u][j] = xr[64 * j]; }
#pragma unroll
    for (int u = 0; u < U; ++u) { float s = 0.f;
#pragma unroll
        for (int j = 0; j < 8; ++j) s += (v[u][j].x * v[u][j].x + v[u][j].y * v[u][j].y) + (v[u][j].z * v[u][j].z + v[u][j].w * v[u][j].w);
        const float r = 1.0f / sqrtf(wave_sum(s) * (1.f / 2048.f) + EPS);
        GAS u32x2* op = (GAS u32x2*)(o + (size_t)(r0 + u) * DM) + lane;
#pragma unroll
        for (int j = 0; j < 8; ++j) { u32x2 w; w.x = cvt_pk_bf16(v[u][j].x * r, v[u][j].y * r); w.y = cvt_pk_bf16(v[u][j].z * r, v[u][j].w * r); op[64 * j] = w; } }
}
template <int U> __device__ __forceinline__ void cvt_rows(const float* x, f16_t* o16, float* RS, int r0, int lane) {
    f32x4 v[U][8];
#pragma unroll
    for (int u = 0; u < U; ++u) { const GAS f32x4* xr = (const GAS f32x4*)(x + (size_t)(r0 + u) * DM) + lane;
#pragma unroll
        for (int j = 0; j < 8; ++j) v[u][j] = xr[64 * j]; }
#pragma unroll
    for (int u = 0; u < U; ++u) { float s = 0.f;
#pragma unroll
        for (int j = 0; j < 8; ++j) s += (v[u][j].x * v[u][j].x + v[u][j].y * v[u][j].y) + (v[u][j].z * v[u][j].z + v[u][j].w * v[u][j].w);
        s = wave_sum(s);
        if (lane == 0) ((GAS float*)RS)[r0 + u] = 1.0f / sqrtf(s * (1.f / 2048.f) + EPS);
        typedef _Float16 f16x4 __attribute__((ext_vector_type(4))); GAS f16x4* hp = (GAS f16x4*)(o16 + (size_t)(r0 + u) * DM) + lane;
#pragma unroll
        for (int j = 0; j < 8; ++j) { f16x4 h; h[0] = (f16_t)v[u][j].x; h[1] = (f16_t)v[u][j].y; h[2] = (f16_t)v[u][j].z; h[3] = (f16_t)v[u][j].w; hp[64 * j] = h; } }
}
__device__ __forceinline__ void reduce_ss(const float* SS, float* RS, int idx, int nthr) {
    for (int i = idx; i < M * 4; i += nthr) { const int row = i >> 2, q = i & 3; const GAS f32x4* p = (const GAS f32x4*)(SS + (size_t)row * 32 + q * 8); const f32x4 a = p[0], b = p[1];
        float s = (a[0] + a[1]) + (a[2] + a[3]) + (b[0] + b[1]) + (b[2] + b[3]); s += __shfl_xor(s, 1); s += __shfl_xor(s, 2);
        if (q == 0) ((GAS float*)RS)[row] = 1.0f / sqrtf(s * (1.f / 2048.f) + EPS); }
}
template <int GL> __device__ __forceinline__ float group_sum(float v) {
#pragma unroll
    for (int o = 1; o < GL; o <<= 1) v += __shfl_xor(v, o);
    return v;
}
struct G8 { float g[8]; };
__device__ __forceinline__ G8 ld_gain8(const float* p) { G8 r; const f32x4 a = *(const GAS f32x4*)p, b = *(const GAS f32x4*)(p + 4); r.g[0] = a[0]; r.g[1] = a[1]; r.g[2] = a[2]; r.g[3] = a[3]; r.g[4] = b[0]; r.g[5] = b[1]; r.g[6] = b[2]; r.g[7] = b[3]; return r; }
__device__ __forceinline__ G8 ones8() { G8 r;
#pragma unroll
    for (int j = 0; j < 8; ++j) r.g[j] = 1.f; return r; }
template <int GL> __device__ __forceinline__ u32x4 norm8(bf16x8 x, const G8& gn, float scale) {
    float f[8], s = 0.f;
#pragma unroll
    for (int j = 0; j < 8; ++j) { f[j] = bf2f(x[j]); s += f[j] * f[j]; }
    s = group_sum<GL>(s); const float r = scale / sqrtf(s * (1.f / (8 * GL)) + EPS);
#pragma unroll
    for (int j = 0; j < 8; ++j) f[j] = f[j] * r * gn.g[j];
    return pack8(f);
}
__device__ __forceinline__ u32x4 scale8(bf16x8 x, float scale) { float f[8];
#pragma unroll
    for (int j = 0; j < 8; ++j) f[j] = bf2f(x[j]) * scale;
    return pack8(f); }
__device__ __forceinline__ u32x4 norm_rope8(bf16x8 x, bf16x8 x2, const G8& gn, float scale, const f32x4* cs  , int c) {
    float f[8], s = 0.f;
#pragma unroll
    for (int j = 0; j < 8; ++j) { f[j] = bf2f(x[j]) + bf2f(x2[j]); s += f[j] * f[j]; }
    s = group_sum<8>(s); const float r = 1.0f / sqrtf(s * (1.f / 64.f) + EPS);
    float o[8];
#pragma unroll
    for (int j = 0; j < 8; ++j) f[j] = f[j] * r * gn.g[j];
#pragma unroll
    for (int j = 0; j < 8; ++j) { const float xp = __shfl_xor(f[j], 4); const float cv = cs[j >> 1][2 * (j & 1)], sv = cs[j >> 1][2 * (j & 1) + 1];
        o[j] = ((c < 4) ? (f[j] * cv - xp * sv) : (xp * sv + f[j] * cv)) * scale; }
    return pack8(o);
}

namespace att {
#define KSWZ(row, colB) ((row) * 256 + ((colB) ^ (((row) & 7) << 4)))
#define K2SWZ(row, colB) ((row) * 128 + ((colB) ^ ((((row) >> 1) & 7) << 4)))
#define SBAR() __builtin_amdgcn_sched_barrier(0)
constexpr int A_V = 0, A_K = 32768, A_K2 = 65536;
constexpr int A_WS = LDSCTL_OFF + 2048, A_TAB = LDSCTL_OFF + 4096;
__device__ __forceinline__ int v_st(int k, int c) { const int kk = (k & ~0xC) | ((k & 4) << 1) | ((k & 8) >> 1); return ((kk >> 3) * 4 + (c >> 5)) * 512 + ((kk & 7) * 32 + (c & 31)) * 2; }
__device__ __forceinline__ int v_rd_base(int lane) { return ((lane & 3) << 3) | (((lane >> 2) & 3) << 6) | (((lane >> 4) & 1) << 5) | (((lane >> 5) & 1) << 8); }
constexpr int v_rd_off(int d0, int ks, int half) { return d0 * 512 + ks * 4096 + half * 2048; }
template <int OFF> __device__ __forceinline__ s16x4 tr_read(int vb) {
    s16x4 r; asm volatile("ds_read_b64_tr_b16 %0, %1 offset:%2" : "=&v"(r) : "v"(vb), "i"(OFF) : "memory"); return r;
}
template <int D0> __device__ __forceinline__ void pv_one(f32x16& od, int vb, bf16x8 pa0, bf16x8 pa1, bf16x8 pa2, bf16x8 pa3) {
    const s16x4 l0 = tr_read<v_rd_off(D0, 0, 0)>(vb), h0 = tr_read<v_rd_off(D0, 0, 1)>(vb), l1 = tr_read<v_rd_off(D0, 1, 0)>(vb), h1 = tr_read<v_rd_off(D0, 1, 1)>(vb);
    const s16x4 l2 = tr_read<v_rd_off(D0, 2, 0)>(vb), h2 = tr_read<v_rd_off(D0, 2, 1)>(vb), l3 = tr_read<v_rd_off(D0, 3, 0)>(vb), h3 = tr_read<v_rd_off(D0, 3, 1)>(vb);
    asm volatile("s_waitcnt lgkmcnt(0)" ::: "memory"); SBAR();
#define PK(L, H) (bf16x8){L[0], L[1], L[2], L[3], H[0], H[1], H[2], H[3]}
    od = __builtin_amdgcn_mfma_f32_32x32x16_bf16(pa0, PK(l0, h0), od, 0, 0, 0);
    od = __builtin_amdgcn_mfma_f32_32x32x16_bf16(pa1, PK(l1, h1), od, 0, 0, 0);
    od = __builtin_amdgcn_mfma_f32_32x32x16_bf16(pa2, PK(l2, h2), od, 0, 0, 0);
    od = __builtin_amdgcn_mfma_f32_32x32x16_bf16(pa3, PK(l3, h3), od, 0, 0, 0);
#undef PK
}
__device__ __forceinline__ float xhalf_max(float v) { auto rr = __builtin_amdgcn_permlane32_swap(__float_as_uint(v), __float_as_uint(v), false, false); return fmaxf(__uint_as_float(rr[0]), __uint_as_float(rr[1])); }
__device__ __forceinline__ float xhalf_sum(float v) { auto rr = __builtin_amdgcn_permlane32_swap(__float_as_uint(v), __float_as_uint(v), false, false); return __uint_as_float(rr[0]) + __uint_as_float(rr[1]); }
constexpr int crow0(int r) { return (r & 3) + 8 * (r >> 2); }

template <int KOFF> __device__ __forceinline__ float sb_half_prod(f32x16& p, const float base, const int dq4, const int hi) {
    float keep[16];
#pragma unroll
    for (int r = 0; r < 16; ++r) { const float e = fast_exp2(fminf(-p[r] * LOG2E, 100.f)), b = fast_rcp(1.f + e); const bool v = KOFF + crow0(r) < dq4; keep[r] = v ? e * b : 1.f; p[r] = v ? b : 0.f; }
    float gh1[4], gh0[4];
#pragma unroll
    for (int g = 0; g < 4; ++g) { const float own = (keep[4 * g] * keep[4 * g + 1]) * (keep[4 * g + 2] * keep[4 * g + 3]);
        auto rr = __builtin_amdgcn_permlane32_swap(__float_as_uint(own), __float_as_uint(own), false, false);
        const float other = __uint_as_float(hi ? rr[0] : rr[1]); gh1[g] = hi ? own : other; gh0[g] = hi ? other : own; }
    float R = base;
#pragma unroll
    for (int g = 3; g >= 0; --g) { float w = hi ? R : R * gh1[g];
        const float b3 = p[4 * g + 3], b2 = p[4 * g + 2], b1 = p[4 * g + 1], b0 = p[4 * g];
        p[4 * g + 3] = b3 * w; w *= keep[4 * g + 3]; p[4 * g + 2] = b2 * w; w *= keep[4 * g + 2]; p[4 * g + 1] = b1 * w; w *= keep[4 * g + 1]; p[4 * g] = b0 * w;
        R = R * (gh1[g] * gh0[g]); }
    return R;
}

template <int MODE>
__device__ __forceinline__ void attn_unit(LAS unsigned char* lds, const bf16_t* Qb, int ldq, const bf16_t* Kb, int ldk, const bf16_t* K2b, const bf16_t* Vb, int ldv, bf16_t* Ob, int ldo,
                                          int q0, float sink2, const float* qgain, const f32x4* rope_rows  ) {
    int tid = threadIdx.x; asm volatile("" : "+v"(tid));
    const int wid = __builtin_amdgcn_readfirstlane(tid >> 6), lane = tid & 63, r32 = lane & 31, hi = lane >> 5;
    constexpr int ND = (MODE == 2) ? 12 : 8;
    bf16x8 qr[ND];
    { const bf16_t* Qw = Qb + (size_t)(wid * 32 + r32) * ldq + hi * 8;
#pragma unroll
      for (int d0 = 0; d0 < ND; ++d0) qr[d0] = *(const GAS bf16x8*)(Qw + d0 * 16);
      constexpr float QSC = (MODE == 1) ? 0.08838834764831845f : (MODE == 2 ? 0.07216878364870323f * LOG2E : 0.08838834764831845f * LOG2E);
      f32x4 gq[8][2], gr[2][4], rcs[2][4];
      if (MODE != 1) {
#pragma unroll
          for (int d0 = 0; d0 < 8; ++d0) { gq[d0][0] = *(const GAS f32x4*)(qgain + d0 * 16 + hi * 8); gq[d0][1] = *(const GAS f32x4*)(qgain + d0 * 16 + hi * 8 + 4); } }
      if (MODE == 2) { const GAS f32x4* rp = (const GAS f32x4*)rope_rows + (size_t)(wid * 32 + r32) * 16;
#pragma unroll
          for (int dd = 0; dd < 2; ++dd) { gr[dd][0] = *(const GAS f32x4*)(qgain + 128 + dd * 16 + hi * 8); gr[dd][1] = *(const GAS f32x4*)(qgain + 128 + dd * 16 + hi * 8 + 4);
              gr[dd][2] = *(const GAS f32x4*)(qgain + 160 + dd * 16 + hi * 8); gr[dd][3] = *(const GAS f32x4*)(qgain + 160 + dd * 16 + hi * 8 + 4);
#pragma unroll
              for (int q = 0; q < 4; ++q) rcs[dd][q] = rp[8 * dd + 4 * hi + q]; } }
      __builtin_amdgcn_sched_barrier(0);
      float rn = QSC, rr = QSC;
      if (MODE != 1) { float s = 0.f;
#pragma unroll
          for (int d0 = 0; d0 < 8; ++d0)
#pragma unroll
              for (int j = 0; j < 8; ++j) { const float f = bf2f(qr[d0][j]); s += f * f; }
          s = xhalf_sum(s); rn = QSC / sqrtf(s * (1.f / 128.f) + EPS);
          if (MODE == 2) { float s2 = 0.f;
#pragma unroll
              for (int d0 = 8; d0 < ND; ++d0)
#pragma unroll
                  for (int j = 0; j < 8; ++j) { const float f = bf2f(qr[d0][j]); s2 += f * f; }
              s2 = xhalf_sum(s2); rr = QSC / sqrtf(s2 * (1.f / 64.f) + EPS); } }
#pragma unroll
      for (int d0 = 0; d0 < 8; ++d0) { float f[8];
          if (MODE != 1) { const f32x4 g0 = gq[d0][0], g1 = gq[d0][1];
#pragma unroll
              for (int j = 0; j < 4; ++j) { f[j] = bf2f(qr[d0][j]) * rn * g0[j]; f[4 + j] = bf2f(qr[d0][4 + j]) * rn * g1[j]; } }
          else {
#pragma unroll
              for (int j = 0; j < 8; ++j) f[j] = bf2f(qr[d0][j]) * rn; }
          qr[d0] = __builtin_bit_cast(bf16x8, pack8(f)); }
      if (MODE == 2) {
#pragma unroll
          for (int dd = 0; dd < 2; ++dd) { float x1[8], x2[8], o1[8], o2[8];
              const f32x4 ga = gr[dd][0], gb = gr[dd][1], gc = gr[dd][2], gd = gr[dd][3];
#pragma unroll
              for (int j = 0; j < 4; ++j) { x1[j] = bf2f(qr[(MODE == 2 ? 8 : 0) + dd][j]) * rr * ga[j]; x1[4 + j] = bf2f(qr[(MODE == 2 ? 8 : 0) + dd][4 + j]) * rr * gb[j];
                  x2[j] = bf2f(qr[(MODE == 2 ? 10 : 0) + dd][j]) * rr * gc[j]; x2[4 + j] = bf2f(qr[(MODE == 2 ? 10 : 0) + dd][4 + j]) * rr * gd[j]; }
#pragma unroll
              for (int j = 0; j < 8; ++j) { const f32x4 cs = rcs[dd][j >> 1]; const float cv = cs[2 * (j & 1)], sv = cs[2 * (j & 1) + 1];
                  o1[j] = x1[j] * cv - x2[j] * sv; o2[j] = x1[j] * sv + x2[j] * cv; }
              qr[(MODE == 2 ? 8 : 0) + dd] = __builtin_bit_cast(bf16x8, pack8(o1)); qr[(MODE == 2 ? 10 : 0) + dd] = __builtin_bit_cast(bf16x8, pack8(o2)); }
      }
    }
    const int qw = q0 + wid * 32;
    int jt0, jt1;
    if (MODE == 0) { jt0 = (q0 >> 6) - 2; jt0 = jt0 < 0 ? 0 : jt0; jt1 = (q0 >> 6) + 3; }
    else if (MODE == 3) { jt0 = 0; jt1 = 3; }
    else { jt0 = 0; jt1 = (q0 >> 6) + 3; }
    const int NT = jt1 - jt0 + 1;
    const int sr = tid >> 4, sc = (tid & 15) * 8, vst0 = v_st(sr, sc), vst1 = v_st(32 + sr, sc), kst0 = KSWZ(sr, sc * 2), kst1 = KSWZ(32 + sr, sc * 2);
    const int s2r = tid >> 3, s2c = (tid & 7) * 8, k2st = K2SWZ(s2r, s2c * 2);
    bf16x8 sk0, sk1, sv0, sv1, sk2;
#define SLOAD(kt) do { const size_t kr0 = (size_t)((kt) * 64 + sr); sk0 = *(const GAS bf16x8*)(Kb + kr0 * ldk + sc); sk1 = *(const GAS bf16x8*)(Kb + (kr0 + 32) * ldk + sc); \
        sv0 = *(const GAS bf16x8*)(Vb + kr0 * ldv + sc); sv1 = *(const GAS bf16x8*)(Vb + (kr0 + 32) * ldv + sc); \
        if (MODE == 2) sk2 = *(const GAS bf16x8*)(K2b + (size_t)((kt) * 64 + s2r) * 64 + s2c); } while (0)
#define SWRITE(b) do { *(LAS bf16x8*)(lds + A_V + (b) * 16384 + vst0) = sv0; *(LAS bf16x8*)(lds + A_V + (b) * 16384 + vst1) = sv1; \
        *(LAS bf16x8*)(lds + A_K + (b) * 16384 + kst0) = sk0; *(LAS bf16x8*)(lds + A_K + (b) * 16384 + kst1) = sk1; \
        if (MODE == 2) *(LAS bf16x8*)(lds + A_K2 + (b) * 8192 + k2st) = sk2; } while (0)
#define TILE(j) (MODE == 1 ? jt1 - (j) : jt0 + (j))
    const int vb0 = (int)(unsigned)(uintptr_t)(lds + A_V) + v_rd_base(lane);
    LAS float* wsf = (LAS float*)(lds + A_WS) + wid * 64;
    const LAS float* tab = (const LAS float*)(lds + A_TAB);
    f32x16 o[4];
#pragma unroll
    for (int d = 0; d < 4; ++d)
#pragma unroll
        for (int r = 0; r < 16; ++r) o[d][r] = 0.f;
    float m_reg = (MODE == 0) ? sink2 : -1e30f, l_reg = (MODE == 0) ? 1.f : 0.f, carry = 1.f;

    bf16x8 tk0, tk1, tv0, tv1, tk2;
#define SLOADB(kt) do { const size_t kr0 = (size_t)((kt) * 64 + sr); tk0 = *(const GAS bf16x8*)(Kb + kr0 * ldk + sc); tk1 = *(const GAS bf16x8*)(Kb + (kr0 + 32) * ldk + sc); \
        tv0 = *(const GAS bf16x8*)(Vb + kr0 * ldv + sc); tv1 = *(const GAS bf16x8*)(Vb + (kr0 + 32) * ldv + sc); \
        if (MODE == 2) tk2 = *(const GAS bf16x8*)(K2b + (size_t)((kt) * 64 + s2r) * 64 + s2c); } while (0)
#define SWRITEB(b) do { *(LAS bf16x8*)(lds + A_V + (b) * 16384 + vst0) = tv0; *(LAS bf16x8*)(lds + A_V + (b) * 16384 + vst1) = tv1; \
        *(LAS bf16x8*)(lds + A_K + (b) * 16384 + kst0) = tk0; *(LAS bf16x8*)(lds + A_K + (b) * 16384 + kst1) = tk1; \
        if (MODE == 2) *(LAS bf16x8*)(lds + A_K2 + (b) * 8192 + k2st) = tk2; } while (0)
    auto compute = [&](const int j, const int buf) __attribute__((always_inline)) {
        const int kt = TILE(j), k0 = kt * 64;
        bool need;
        if (MODE == 0) need = (k0 + 63 >= qw - 127) && (k0 <= qw + 31);
        else if (MODE == 3) need = true;
        else need = (k0 <= qw + 31);
        if (need) {
            f32x16 p0, p1;
#pragma unroll
            for (int r = 0; r < 16; ++r) { p0[r] = 0.f; p1[r] = 0.f; }
            { const LAS unsigned char* Kt = lds + A_K + buf * 16384;
#pragma unroll
              for (int d0 = 0; d0 < 8; ++d0) { const int cb = (d0 * 16 + hi * 8) * 2;
                  const bf16x8 a0 = *(const LAS bf16x8*)(Kt + KSWZ(r32, cb)), a1 = *(const LAS bf16x8*)(Kt + KSWZ(32 + r32, cb));
                  p0 = __builtin_amdgcn_mfma_f32_32x32x16_bf16(a0, qr[d0], p0, 0, 0, 0); p1 = __builtin_amdgcn_mfma_f32_32x32x16_bf16(a1, qr[d0], p1, 0, 0, 0); }
              if (MODE == 2) { const LAS unsigned char* K2t = lds + A_K2 + buf * 8192;
#pragma unroll
                  for (int d2 = 0; d2 < 4; ++d2) { const int cb = (d2 * 16 + hi * 8) * 2;
                      const bf16x8 a0 = *(const LAS bf16x8*)(K2t + K2SWZ(r32, cb)), a1 = *(const LAS bf16x8*)(K2t + K2SWZ(32 + r32, cb));
                      p0 = __builtin_amdgcn_mfma_f32_32x32x16_bf16(a0, qr[(MODE == 2 ? 8 : 0) + d2], p0, 0, 0, 0); p1 = __builtin_amdgcn_mfma_f32_32x32x16_bf16(a1, qr[(MODE == 2 ? 8 : 0) + d2], p1, 0, 0, 0); } } }
            const int dq4 = qw + r32 - k0 - 4 * hi;
            if (MODE == 1) {
                carry = sb_half_prod<32>(p1, carry, dq4, hi);
                carry = sb_half_prod<0>(p0, carry, dq4, hi);
            } else {
                if (MODE == 0) {
#pragma unroll
                    for (int r = 0; r < 16; ++r) { p0[r] += tab[dq4 + 96 - crow0(r)]; p1[r] += tab[dq4 + 96 - 32 - crow0(r)]; }
                }
                if (MODE == 2) { if (k0 + 63 > qw) {
#pragma unroll
                    for (int r = 0; r < 16; ++r) { if (crow0(r) > dq4) p0[r] = -1e30f; if (32 + crow0(r) > dq4) p1[r] = -1e30f; } } }
                float pmax = p0[0];
#pragma unroll
                for (int r = 1; r < 16; ++r) pmax = fmaxf(pmax, p0[r]);
#pragma unroll
                for (int r = 0; r < 16; ++r) pmax = fmaxf(pmax, p1[r]);
                pmax = xhalf_max(pmax);
                const float mn = fmaxf(m_reg, pmax), alpha = fast_exp2(m_reg - mn); m_reg = mn;
                float ps = 0.f;
#pragma unroll
                for (int r = 0; r < 16; ++r) { p0[r] = fast_exp2(p0[r] - mn); p1[r] = fast_exp2(p1[r] - mn); ps += p0[r] + p1[r]; }
                ps = xhalf_sum(ps);
                l_reg = l_reg * alpha + ps;
                if (__any(alpha < 1.f)) { if (hi == 0) wsf[r32] = alpha; asm volatile("s_waitcnt lgkmcnt(0)" ::: "memory");
#pragma unroll
                    for (int r = 0; r < 16; ++r) { const float a = wsf[crow0(r) + 4 * hi];
#pragma unroll
                        for (int d = 0; d < 4; ++d) o[d][r] *= a; }
                    asm volatile("s_waitcnt lgkmcnt(0)" ::: "memory"); }
            }
            bf16x8 pa0, pa1, pa2, pa3;
#define PK4(P, BASE, OUT) do { unsigned a0 = cvt_pk_bf16(P[BASE + 0], P[BASE + 1]), a1 = cvt_pk_bf16(P[BASE + 2], P[BASE + 3]); \
    unsigned b0 = cvt_pk_bf16(P[BASE + 4], P[BASE + 5]), b1 = cvt_pk_bf16(P[BASE + 6], P[BASE + 7]); \
    auto r0 = __builtin_amdgcn_permlane32_swap(a0, b0, false, false); auto r1 = __builtin_amdgcn_permlane32_swap(a1, b1, false, false); \
    u32x4 w = {r0[0], r1[0], r0[1], r1[1]}; OUT = __builtin_bit_cast(bf16x8, w); } while (0)
            PK4(p0, 0, pa0); PK4(p0, 8, pa1); PK4(p1, 0, pa2); PK4(p1, 8, pa3);
#undef PK4
            const int vb = vb0 + buf * 16384;
            pv_one<0>(o[0], vb, pa0, pa1, pa2, pa3); pv_one<1>(o[1], vb, pa0, pa1, pa2, pa3); pv_one<2>(o[2], vb, pa0, pa1, pa2, pa3); pv_one<3>(o[3], vb, pa0, pa1, pa2, pa3);
        }
    };
    SLOAD(TILE(0)); SWRITE(0); __syncthreads();
    if (NT > 1) SLOAD(TILE(1));
    if (NT > 2) SLOADB(TILE(2));
    for (int j = 0; j < NT; j += 2) {
        compute(j, 0);
        if (j + 1 < NT) { SWRITE(1); if (j + 3 < NT) SLOAD(TILE(j + 3)); }
        __syncthreads();
        if (j + 1 < NT) {
            compute(j + 1, 1);
            if (j + 2 < NT) { SWRITEB(0); if (j + 4 < NT) SLOADB(TILE(j + 4)); }
            __syncthreads();
        }
    }
    LAS float* ot = (LAS float*)(lds + wid * 16384);
#pragma unroll
    for (int d = 0; d < 4; ++d)
#pragma unroll
        for (int r = 0; r < 16; ++r) ot[(crow0(r) + 4 * hi) * 128 + d * 32 + r32] = o[d][r];
    if (MODE != 1) { if (hi == 0) wsf[r32] = l_reg; }
    asm volatile("s_waitcnt lgkmcnt(0)" ::: "memory");
#pragma unroll
    for (int i = 0; i < 8; ++i) { const int row = i * 4 + (lane >> 4), c8 = lane & 15;
        const f32x4 a = *(const LAS f32x4*)(ot + row * 128 + c8 * 8), b = *(const LAS f32x4*)(ot + row * 128 + c8 * 8 + 4);
        const float rl = (MODE != 1) ? 1.f / wsf[row] : 1.f;
        float v[8] = {a[0] * rl, a[1] * rl, a[2] * rl, a[3] * rl, b[0] * rl, b[1] * rl, b[2] * rl, b[3] * rl};
        *(GAS u32x4*)(Ob + (size_t)(wid * 32 + row) * ldo + c8 * 8) = pack8(v); }
    __syncthreads();
#undef SLOAD
#undef SWRITE
#undef SLOADB
#undef SWRITEB
#undef TILE
}

__device__ __forceinline__ void swa_band_unit(LAS unsigned char* lds, const bf16_t* Qg, int ldq, const bf16_t* Kh, const bf16_t* Vh, bf16_t* Og, int ldo, int q0, int h0,
                                              const float* sinks, const float* qgain, const LAS float* tabs) {
    int tid = threadIdx.x; asm volatile("" : "+v"(tid));
    const int wid = __builtin_amdgcn_readfirstlane(tid >> 6), lane = tid & 63, r32 = lane & 31, hi = lane >> 5;
    const int t0 = (q0 >> 6) - 2;
    { const int sr = tid >> 4, sc = (tid & 15) * 8, vst0 = v_st(sr, sc), vst1 = v_st(32 + sr, sc), kst0 = KSWZ(sr, sc * 2), kst1 = KSWZ(32 + sr, sc * 2);
      bf16x8 sk[4][2], sv[4][2];
#pragma unroll
      for (int tt = 0; tt < 4; ++tt) { const int kt = t0 + tt; if (kt >= 0) { const size_t kr0 = (size_t)(kt * 64 + sr);
          sk[tt][0] = *(const GAS bf16x8*)(Kh + kr0 * 128 + sc); sk[tt][1] = *(const GAS bf16x8*)(Kh + (kr0 + 32) * 128 + sc);
          sv[tt][0] = *(const GAS bf16x8*)(Vh + kr0 * 128 + sc); sv[tt][1] = *(const GAS bf16x8*)(Vh + (kr0 + 32) * 128 + sc); } }
#pragma unroll
      for (int tt = 0; tt < 4; ++tt) { const int kt = t0 + tt; if (kt >= 0) {
          *(LAS bf16x8*)(lds + tt * 16384 + kst0) = sk[tt][0]; *(LAS bf16x8*)(lds + tt * 16384 + kst1) = sk[tt][1];
          *(LAS bf16x8*)(lds + 65536 + tt * 16384 + vst0) = sv[tt][0]; *(LAS bf16x8*)(lds + 65536 + tt * 16384 + vst1) = sv[tt][1]; } }
    }
    __syncthreads();
    const int vb0 = (int)(unsigned)(uintptr_t)(lds + 65536) + v_rd_base(lane);
    LAS float* wsf = (LAS float*)(lds + A_WS) + wid * 64;
    for (int pass = 0; pass < 2; ++pass) {
        const int task = wid + 8 * pass, g = task >> 2, rbk = task & 3, qw = q0 + rbk * 32;
        bf16x8 qr[8];
        { const bf16_t* Qw = Qg + (size_t)(rbk * 32 + r32) * ldq + g * 128 + hi * 8;
#pragma unroll
          for (int d0 = 0; d0 < 8; ++d0) qr[d0] = *(const GAS bf16x8*)(Qw + d0 * 16);
          f32x4 gq[8][2];
#pragma unroll
          for (int d0 = 0; d0 < 8; ++d0) { gq[d0][0] = *(const GAS f32x4*)(qgain + d0 * 16 + hi * 8); gq[d0][1] = *(const GAS f32x4*)(qgain + d0 * 16 + hi * 8 + 4); }
          __builtin_amdgcn_sched_barrier(0);
          float s = 0.f;
#pragma unroll
          for (int d0 = 0; d0 < 8; ++d0)
#pragma unroll
              for (int j = 0; j < 8; ++j) { const float f = bf2f(qr[d0][j]); s += f * f; }
          s = xhalf_sum(s); const float rn = (0.08838834764831845f * LOG2E) / sqrtf(s * (1.f / 128.f) + EPS);
#pragma unroll
          for (int d0 = 0; d0 < 8; ++d0) { float f[8];
#pragma unroll
              for (int j = 0; j < 4; ++j) { f[j] = bf2f(qr[d0][j]) * rn * gq[d0][0][j]; f[4 + j] = bf2f(qr[d0][4 + j]) * rn * gq[d0][1][j]; }
              qr[d0] = __builtin_bit_cast(bf16x8, pack8(f)); } }
        f32x16 o[4];
#pragma unroll
        for (int d = 0; d < 4; ++d)
#pragma unroll
            for (int r = 0; r < 16; ++r) o[d][r] = 0.f;
        float m_reg = ((const GAS float*)sinks)[h0 + g] * LOG2E, l_reg = 1.f;
        const LAS float* tab = tabs + (h0 + g) * 320;
        for (int tt = 0; tt < 4; ++tt) { const int kt = t0 + tt, k0 = kt * 64;
            if (kt < 0 || k0 + 63 < qw - 127 || k0 > qw + 31) continue;
            f32x16 p0, p1;
#pragma unroll
            for (int r = 0; r < 16; ++r) { p0[r] = 0.f; p1[r] = 0.f; }
            { const LAS unsigned char* Kt = lds + tt * 16384;
#pragma unroll
              for (int d0 = 0; d0 < 8; ++d0) { const int cb = (d0 * 16 + hi * 8) * 2;
                  const bf16x8 a0 = *(const LAS bf16x8*)(Kt + KSWZ(r32, cb)), a1 = *(const LAS bf16x8*)(Kt + KSWZ(32 + r32, cb));
                  p0 = __builtin_amdgcn_mfma_f32_32x32x16_bf16(a0, qr[d0], p0, 0, 0, 0); p1 = __builtin_amdgcn_mfma_f32_32x32x16_bf16(a1, qr[d0], p1, 0, 0, 0); } }
            const int dq4 = qw + r32 - k0 - 4 * hi;
#pragma unroll
            for (int r = 0; r < 16; ++r) { p0[r] += tab[dq4 + 96 - crow0(r)]; p1[r] += tab[dq4 + 96 - 32 - crow0(r)]; }
            float pmax = p0[0];
#pragma unroll
            for (int r = 1; r < 16; ++r) pmax = fmaxf(pmax, p0[r]);
#pragma unroll
            for (int r = 0; r < 16; ++r) pmax = fmaxf(pmax, p1[r]);
            pmax = xhalf_max(pmax);
            const float mn = fmaxf(m_reg, pmax), alpha = fast_exp2(m_reg - mn); m_reg = mn;
            float ps = 0.f;
#pragma unroll
            for (int r = 0; r < 16; ++r) { p0[r] = fast_exp2(p0[r] - mn); p1[r] = fast_exp2(p1[r] - mn); ps += p0[r] + p1[r]; }
            ps = xhalf_sum(ps);
            l_reg = l_reg * alpha + ps;
            if (__any(alpha < 1.f)) { if (hi == 0) wsf[r32] = alpha; asm volatile("s_waitcnt lgkmcnt(0)" ::: "memory");
#pragma unroll
                for (int r = 0; r < 16; ++r) { const float a = wsf[crow0(r) + 4 * hi];
#pragma unroll
                    for (int d = 0; d < 4; ++d) o[d][r] *= a; }
                asm volatile("s_waitcnt lgkmcnt(0)" ::: "memory"); }
            bf16x8 pa0, pa1, pa2, pa3;
#define PK4(P, BASE, OUT) do { unsigned a0 = cvt_pk_bf16(P[BASE + 0], P[BASE + 1]), a1 = cvt_pk_bf16(P[BASE + 2], P[BASE + 3]); \
    unsigned b0 = cvt_pk_bf16(P[BASE + 4], P[BASE + 5]), b1 = cvt_pk_bf16(P[BASE + 6], P[BASE + 7]); \
    auto r0 = __builtin_amdgcn_permlane32_swap(a0, b0, false, false); auto r1 = __builtin_amdgcn_permlane32_swap(a1, b1, false, false); \
    u32x4 w = {r0[0], r1[0], r0[1], r1[1]}; OUT = __builtin_bit_cast(bf16x8, w); } while (0)
            PK4(p0, 0, pa0); PK4(p0, 8, pa1); PK4(p1, 0, pa2); PK4(p1, 8, pa3);
#undef PK4
            const int vb = vb0 + tt * 16384;
            pv_one<0>(o[0], vb, pa0, pa1, pa2, pa3); pv_one<1>(o[1], vb, pa0, pa1, pa2, pa3); pv_one<2>(o[2], vb, pa0, pa1, pa2, pa3); pv_one<3>(o[3], vb, pa0, pa1, pa2, pa3);
        }
        if (hi == 0) wsf[r32] = l_reg; asm volatile("s_waitcnt lgkmcnt(0)" ::: "memory");
#pragma unroll
        for (int r = 0; r < 16; ++r) { const int row = crow0(r) + 4 * hi; const float rl = 1.f / wsf[row];
            GAS unsigned short* op = (GAS unsigned short*)(Og + (size_t)(rbk * 32 + row) * ldo + g * 128 + r32);
#pragma unroll
            for (int d = 0; d < 4; ++d) op[d * 32] = (unsigned short)(cvt_pk_bf16(o[d][r] * rl, 0.f) & 0xffffu); }
        asm volatile("s_waitcnt lgkmcnt(0)" ::: "memory");
    }
    __syncthreads();
}
#undef KSWZ
#undef K2SWZ
#undef SBAR
}

struct SchedXkv { pg8::TileOrder T; const char* A; const char* B;
    __device__ bool next(int i, pg8::GUnit& u) const { const long L = (long)i * T.G + T.c; if (L >= 256) return false; const int l = (int)L >> 6, r = (int)L & 63, pm = r >> 2, pn = r & 3;
        u.A = A + (size_t)pm * 256 * DM * 2; u.B = B + (size_t)l * 4 * MiB + (size_t)pn * 256 * DM * 2; u.nt = 32; u.pm = l * 16 + pm; u.pn = pn; u.seg = 0; return true; } };
__device__ __forceinline__ unsigned long long pt_ld(LAS unsigned char* lds, int k) {
    asm volatile("" ::: "memory");
    const unsigned long long v = ((const LAS unsigned long long*)(lds + PT_OFF))[k];
    const unsigned lo = __builtin_amdgcn_readfirstlane((unsigned)v), hi = __builtin_amdgcn_readfirstlane((unsigned)(v >> 32));
    return ((unsigned long long)hi << 32) | lo;
}
#define INP(k) ((const float*)pt_ld(F.lds, (k)))
#define WSP() ((unsigned char*)pt_ld(F.lds, 28))
#define OUTP() ((float*)pt_ld(F.lds, 27))
__global__ void __launch_bounds__(NWAVES * 64, 2) trunk_fwd(Args args) {
    extern __shared__ __attribute__((aligned(16))) unsigned char lds_raw[];
    Frame F;
    F.lds = (LAS unsigned char*)lds_raw;
    volatile LAS unsigned* MISC = (volatile LAS unsigned*)(F.lds + MISC_OFF);
    F.tid = threadIdx.x; F.lane = F.tid & 63; F.wave = __builtin_amdgcn_readfirstlane(F.tid >> 6);
    F.G = gridDim.x; const int bx = blockIdx.x; const int vcu = (F.G % 8 == 0) ? (bx % 8) * (F.G / 8) + bx / 8 : bx;
    F.gw = vcu * NWAVES + F.wave; F.NGW = F.G * NWAVES;
    for (int u = F.tid; u < (LDS_BYTES - LDSCTL_OFF) / 4; u += NWAVES * 64) ((LAS unsigned*)(F.lds + LDSCTL_OFF))[u] = 0u;
    __syncthreads();
    if (F.tid == 0) { LAS unsigned long long* PT = (LAS unsigned long long*)(F.lds + PT_OFF);
#pragma unroll
        for (int k = 0; k < 27; ++k) PT[k] = (unsigned long long)args.in[k];
        PT[27] = (unsigned long long)args.out; PT[28] = (unsigned long long)args.ws; }
    __syncthreads();
    const int lo = args.ph_lo, hi = args.ph_hi;
    const bool use_bar = (hi - lo) > 1;
    XcdBarrier bar; bar.bar = (unsigned*)(WSP() + WS_CTL) + CW_BAR; bar.x = 0; bar.st = nullptr;
    if (use_bar) bar = xcd_barrier_post((unsigned*)(WSP() + WS_CTL) + CW_BAR, MISC + 8);
#define IN(k) (lo <= (k) && (k) < hi)
#define SEAM(k) do { if (IN(k) && IN((k) + 1)) xcd_barrier(bar); } while (0)
#define WSB(off) ((bf16_t*)(ws + (off)))
    LAS float* scr = (LAS float*)(F.lds + F.wave * 16384);

#define PHASE_PROLOG(lv) int LN = threadIdx.x & 63; asm volatile("" : "+v"(LN)); int LQ = (lv); asm volatile("" : "+s"(LQ)); int BX = blockIdx.x; asm volatile("" : "+s"(BX)); \
    int GG = gridDim.x; asm volatile("" : "+s"(GG)); const int VC = (GG % 8 == 0) ? (BX % 8) * (GG / 8) + BX / 8 : BX, GW = VC * NWAVES + F.wave, NGW = GG * NWAVES; (void)LN; (void)LQ; (void)GW; (void)NGW; (void)VC;
    if (PHON(18) && IN(0)) { PHASE_PROLOG(0)
        unsigned char* ws = WSP();
        for (int l = 0; l < DEPTH; ++l) {
            const int nit = (2048 / 64) * (1024 / 32);
            for (int it = GW; it < nit; it += NGW)
                transpose_item(INP(20) + (size_t)l * 2048 * 1024, 2048, 1024, WSB(WS_WXKV + (size_t)l * 4 * MiB), 1024 / 32, INP(18) + l * 2048, 0, scr, it, LN);
        }
        const float* mem = INP(1);
        for (int r0 = GW * 2; r0 < MMEM; r0 += NGW * 2) rms_rows<2>(mem, WSB(WS_MEMN), r0, LN);
        { const GAS int* positions = (const GAS int*)INP(2); GAS f32x2* ROPE = (GAS f32x2*)(ws + WS_ROPE);
          for (int idx = GW * 64 + LN; idx < M * 32; idx += NGW * 64) { const int row = idx >> 5, i = idx & 31;
              const float inv = exp2f(-(float)i * (13.287712379549449f / 32.f)); float sn, cs; sincosf((float)positions[row] * inv, &sn, &cs); ROPE[idx] = (f32x2){cs, sn}; } }
    }
    SEAM(0);
    if (PHON(19) && IN(1)) { PHASE_PROLOG(0)
        unsigned char* ws = WSP();
        SchedXkv S; S.T.G = GG; S.T.c = BX; S.A = (const char*)WSB(WS_MEMN); S.B = (const char*)(ws + WS_WXKV);
        pg8::EpiStore E{WSB(WS_XKV), 1024, 0, 0, nullptr, 3};
        pg8::gemm_phase<pg8::EpiStore, SchedXkv, true, true>(F.lds, DM, DM, S, E);
    }
    SEAM(1);
    if (PHON(20) && IN(2)) { PHASE_PROLOG(0)
        unsigned char* ws = WSP(); const float* g = INP(22);
        for (int r = GW; r < DEPTH * MMEM; r += NGW) { const int l = r / MMEM; const int h = LN >> 4, c = LN & 15; const int bb = (r >> 8) & 15, ss = r & 255;
            bf16_t* p = WSB(WS_XKV) + ((size_t)(((l * 16 + bb) * 4 + h) * 2 + 0) * 256 + ss) * 128 + c * 8; const G8 gn = ld_gain8(g + l * 128 + c * 8); *(GAS u32x4*)p = norm8<16>(*(const GAS bf16x8*)p, gn, 1.f); }
    }
    SEAM(2);

    for (int l = 0; l < DEPTH; ++l) {
        const int P = NPRE + l * NP;
        if (PHON(0) && IN(P + 0)) { PHASE_PROLOG(l)
            unsigned char* ws = WSP(); unsigned char* WL = ws + WS_WL;
#define CJ(wi, K_, Ns_, off_, Nd_, gi, mt) { const int n = ((K_) / 64) * ((Nd_) / 32); if (r >= 0 && r < n) { const float* gn = (gi) >= 0 ? INP((gi) < 0 ? 0 : (gi)) + (size_t)LQ * (K_) : nullptr; \
                transpose_item(INP(wi) + (size_t)LQ * (K_) * (Ns_), (K_), (Ns_), (bf16_t*)(WL + (off_)), (Nd_) / 32, gn, (mt), scr, r, LN); } r -= n; }
            constexpr int TOTAL = (2048 / 64) * (LDI / 32) + (2048 / 64) * (2 * DFF / 32) + (DFF / 64) * (2048 / 32) + 2 * (2048 / 64) * (2048 / 32) + (2048 / 64) * (512 / 32) + (512 / 64) * (2048 / 32) + (512 / 64) * (1024 / 32) + (512 / 64) * (768 / 32);
            for (int it = GW; it < TOTAL; it += NGW) { int r = it;
                CJ(5, 2048, IN_W, WL_IN, LDI, 4, 1 | 4)
                CJ(25, 2048, 2 * DFF, WL_GU, 2 * DFF, 24, 2 | 4)
                CJ(26, DFF, 2048, WL_DN, 2048, -1, 0)
                CJ(15, 2048, 2048, WL_BR, 2048, -1, 0)
                CJ(16, 2048, 2048, WL_OUT, 2048, -1, 0)
                CJ(19, 2048, 512, WL_XQ, 512, 17, 0 | 4)
                CJ(23, 512, 2048, WL_XO, 2048, -1, 0)
                CJ(12, 512, 1024, WL_UKV, 1024, 10, 0)
                CJ(11, 512, 768, WL_UQ, 768, 9, 0)
            }
#undef CJ
            if (LQ == 0) { const float* xcur = INP(0); for (int r0 = GW * 4; r0 < M; r0 += NGW * 4) cvt_rows<4>(xcur, (f16_t*)(ws + WS_X16), (float*)(ws + WS_RS), r0, LN); }
            else reduce_ss((const float*)(ws + WS_SS), (float*)(ws + WS_RS), GW * 64 + LN, NGW * 64);
        }
        SEAM(P + 0);
        if (PHON(1) && IN(P + 1)) { PHASE_PROLOG(l)
            unsigned char* ws = WSP();
            pg8::SchedIn S; S.init(WSB(WS_X16), WSB(WS_WL + WL_IN), GG, BX);
            pg8::EpiStore E{WSB(WS_IN), LDI, C_G / 256, C_KR / 256, nullptr, 1, (const float*)(ws + WS_RS)};
            pg8::gemm_phase<pg8::EpiStore, pg8::SchedIn, true, true, true>(F.lds, DM, DM, S, E);
        }
        SEAM(P + 1);
        if (PHON(2) && IN(P + 2)) { PHASE_PROLOG(l)
            unsigned char* ws = WSP(); bf16_t* INb = WSB(WS_IN); bf16_t* KR = WSB(WS_KR); const bf16_t* KR2 = WSB(WS_KR2); bf16_t* KAc = WSB(WS_KA);
            const float* gk = INP(7) + LQ * 128; const float* kg = INP(14) + LQ * 192;
            const int c16 = LN & 15, h4 = LN >> 4; const GAS f32x4* ROPE = (const GAS f32x4*)(ws + WS_ROPE);
            const G8 gk8 = ld_gain8(gk + c16 * 8), gr8 = ld_gain8(kg + 128 + (LN & 7) * 8), one = ones8();
            constexpr int U = 4;
            for (int r0 = GW * U; r0 < M; r0 += NGW * U) {
                bf16x8 kav[U], cqv[U], ckvv[U], krv[U], kr2[U]; f32x4 cs[U][4];
#pragma unroll
                for (int u = 0; u < U; ++u) { const bf16_t* row = INb + (size_t)(r0 + u) * LDI;
                    kav[u] = *(const GAS bf16x8*)(KAc + ((size_t)(((r0 + u) >> 11) * 2 + (h4 & 1)) * SEQ + ((r0 + u) & (SEQ - 1))) * 128 + c16 * 8);
                    cqv[u] = *(const GAS bf16x8*)(row + C_CQ + LN * 8); ckvv[u] = *(const GAS bf16x8*)(row + C_CKV + LN * 8); krv[u] = *(const GAS bf16x8*)(row + C_KR + (LN & 7) * 8); kr2[u] = *(const GAS bf16x8*)(KR2 + (size_t)(r0 + u) * 256 + (LN & 7) * 8);
#pragma unroll
                    for (int q = 0; q < 4; ++q) cs[u][q] = ROPE[(size_t)(r0 + u) * 16 + (LN & 3) * 4 + q]; }
#pragma unroll
                for (int u = 0; u < U; ++u) { bf16_t* row = INb + (size_t)(r0 + u) * LDI;
                    { const u32x4 w = norm8<16>(kav[u], gk8, 1.f); if (LN < 32) *(GAS u32x4*)(KAc + ((size_t)(((r0 + u) >> 11) * 2 + h4) * SEQ + ((r0 + u) & (SEQ - 1))) * 128 + c16 * 8) = w; }
                    { float sq = 0.f, sk = 0.f;
#pragma unroll
                      for (int j = 0; j < 8; ++j) { const float a = bf2f(cqv[u][j]), b = bf2f(ckvv[u][j]); sq += a * a; sk += b * b; }
                      sq = wave_sum(sq); sk = wave_sum(sk);
                      if (LN == 0) { GAS float* rq = (GAS float*)(ws + WS_RS + 256 * 1024); rq[r0 + u] = 1.0f / sqrtf(sq * (1.f / 512.f) + EPS); rq[65536 + r0 + u] = 1.0f / sqrtf(sk * (1.f / 512.f) + EPS); } }
                    { const u32x4 w = norm_rope8(krv[u], kr2[u], gr8, 1.f, cs[u], LN & 7); if (LN < 8) *(GAS u32x4*)(KR + (size_t)(r0 + u) * 64 + LN * 8) = w; } }
            }
        }
        SEAM(P + 2);
        if (PHON(3) && IN(P + 3)) { PHASE_PROLOG(l)
            { unsigned char* ws = WSP(); pg8::SchedSimple S; S.init(WSB(WS_IN) + C_CQ, LDI, WSB(WS_WL + WL_UQ), 512, M, 768, 512, GG, GG - 1 - BX);
              pg8::EpiStore E{WSB(WS_QC), 768, 0, 0, nullptr, 0, (const float*)(ws + WS_RS + 256 * 1024)};
              pg8::gemm_phase<pg8::EpiStore, pg8::SchedSimple, true, true>(F.lds, LDI, 512, S, E); }
            { unsigned char* ws = WSP(); pg8::SchedSimple S; S.init(WSB(WS_IN) + C_CKV, LDI, WSB(WS_WL + WL_UKV), 512, M, 1024, 512, GG, BX);
              pg8::EpiUkv E{WSB(WS_KVC), INP(14) + LQ * 192, (LAS float*)(F.lds + LDSCTL_OFF + 6144), (const float*)(ws + WS_RS + 512 * 1024)};
              pg8::gemm_phase<pg8::EpiUkv, pg8::SchedSimple, true, true>(F.lds, LDI, 512, S, E); }
        }
        SEAM(P + 3);
        if (PHON(5) && IN(P + 5)) { PHASE_PROLOG(l)
            for (int u = VC; u < BATCH * 16; u += GG) { const int pr = u & 3, h = (u >> 2) & 3, b = u >> 4; const size_t rb = (size_t)b * SEQ;
                for (int ps = 0; ps < 2; ++ps) { const int q0 = (ps == 0 ? 7 - pr : pr) * 256; unsigned char* ws = WSP();
                    att::attn_unit<1>(F.lds, WSB(WS_IN) + (rb + q0) * LDI + C_QB + h * 128, LDI, WSB(WS_KB) + (size_t)(b * 4 + h) * SEQ * 128, 128, nullptr, WSB(WS_VB) + (size_t)(b * 4 + h) * SEQ * 128, 128,
                                      WSB(WS_XN) + (rb + q0) * DM + 1024 + h * 128, DM, q0, 0.f, nullptr, nullptr); } }
            { { int tid = threadIdx.x; asm volatile("" : "+v"(tid));
                const GAS float* rel_bias = (const GAS float*)INP(3);
                if (tid < 320) { const int rel = tid - 96; int bk = 0; const bool inw = rel >= 0 && rel < 128;
                    if (inw) { if (rel < 16) bk = rel; else { bk = 16 + (int)(logf((float)rel / 16.f) / logf(8.f) * 16.f); bk = bk > 31 ? 31 : bk; } }
#pragma unroll
                    for (int hh = 0; hh < 8; ++hh) ((LAS float*)(F.lds + att::A_TAB))[hh * 320 + tid] = inw ? rel_bias[bk * 8 + hh] * LOG2E : -1e30f; }
                __syncthreads(); }
              for (int u = VC; u < BATCH * 32; u += GG) { const int blk = u & 15, kvh = (u >> 4) & 1, b = u >> 5, q0 = blk * 128; const size_t rb = (size_t)b * SEQ; unsigned char* ws = WSP();
                att::swa_band_unit(F.lds, WSB(WS_IN) + (rb + q0) * LDI + C_QA + kvh * 512, LDI, WSB(WS_KA) + (size_t)(b * 2 + kvh) * SEQ * 128, WSB(WS_VA) + (size_t)(b * 2 + kvh) * SEQ * 128,
                                   WSB(WS_XN) + (rb + q0) * DM + kvh * 512, DM, q0, kvh * 4, INP(8) + LQ * 8, INP(6) + LQ * 128, (const LAS float*)(F.lds + att::A_TAB)); } }
            for (int u = VC; u < BATCH * 16; u += GG) { const int pr = u & 3, h = (u >> 2) & 3, b = u >> 4; const size_t rb = (size_t)b * SEQ;
                for (int ps = 0; ps < 2; ++ps) { const int q0 = (ps == 0 ? 7 - pr : pr) * 256;
                    unsigned char* ws = WSP(); const bf16_t* QC = WSB(WS_QC); const bf16_t* KVC = WSB(WS_KVC); const bf16_t* KR = WSB(WS_KR); bf16_t* OCAT = WSB(WS_XN); const float* qg = INP(13) + LQ * 192; const GAS f32x4* ROPE = (const GAS f32x4*)(ws + WS_ROPE);
                    att::attn_unit<2>(F.lds, QC + (rb + q0) * 768 + h * 192, 768, KVC + (size_t)(b * 4 + h) * SEQ * 128, 128, KR + rb * 64, KVC + 16 * MiB + (size_t)(b * 4 + h) * SEQ * 128, 128,
                                      OCAT + (rb + q0) * DM + 1536 + h * 128, DM, q0, 0.f, qg, (const f32x4*)(ROPE + (rb + q0) * 16)); } }
        }
        SEAM(P + 5);
        if (PHON(6) && IN(P + 6)) { PHASE_PROLOG(l)
            unsigned char* ws = WSP();
            pg8::SchedBranch S; S.init(WSB(WS_XN), WSB(WS_WL + WL_BR), GG, BX);
            pg8::EpiBranch E{WSB(WS_IN) + C_G, (bf16_t*)OUTP()};
            pg8::gemm_phase<pg8::EpiBranch, pg8::SchedBranch, true, true>(F.lds, DM, DM, S, E);
        }
        SEAM(P + 6);
        if (PHON(7) && IN(P + 7)) { PHASE_PROLOG(l)
            unsigned char* ws = WSP();
            pg8::SchedSimple S; S.init((const bf16_t*)OUTP(), DM, WSB(WS_WL + WL_OUT), DM, M, DM, DM, GG, BX);
            pg8::EpiResX E{(f16_t*)(ws + WS_X16), (float*)(ws + WS_SS)};
            pg8::gemm_phase<pg8::EpiResX, pg8::SchedSimple, false, true>(F.lds, DM, DM, S, E);
        }
        SEAM(P + 7);
        if (PHON(9) && IN(P + 9)) { PHASE_PROLOG(l)
            unsigned char* ws = WSP();
            pg8::SchedSimple S; S.init(WSB(WS_X16), DM, WSB(WS_WL + WL_XQ), DM, M, 512, DM, GG, BX);
            pg8::EpiStore E{WSB(WS_XQ), 512, 0, 0, (const float*)(ws + WS_SS)};
            pg8::gemm_phase<pg8::EpiStore, pg8::SchedSimple, true, true, true>(F.lds, DM, DM, S, E);
        }
        SEAM(P + 9);
        if (PHON(10) && IN(P + 10)) { PHASE_PROLOG(l)
            unsigned char* ws = WSP(); const bf16_t* XQ = WSB(WS_XQ); bf16_t* XO = WSB(WS_XO); const float* g = INP(21) + LQ * 128;
            const bf16_t* XKVl = WSB(WS_XKV) + (size_t)LQ * MMEM * 1024;
            for (int u = VC; u < BATCH * 32; u += GG) { const int i = u & 7, h = (u >> 3) & 3, b = u >> 5, q0 = i * 256; const size_t rb = (size_t)b * SEQ;
                const bf16_t* Kb = XKVl + (size_t)((b * 4 + h) * 2) * 256 * 128;
                att::attn_unit<3>(F.lds, XQ + (rb + q0) * 512 + h * 128, 512, Kb, 128, nullptr, Kb + 256 * 128, 128, XO + (rb + q0) * 512 + h * 128, 512, q0, 0.f, g, nullptr); }
        }
        SEAM(P + 10);
        if (PHON(11) && IN(P + 11)) { PHASE_PROLOG(l)
            unsigned char* ws = WSP();
            pg8::SchedSimple S; S.init(WSB(WS_XO), 512, WSB(WS_WL + WL_XO), 512, M, DM, 512, GG, BX);
            pg8::EpiResX E{(f16_t*)(ws + WS_X16), (float*)(ws + WS_SS)};
            pg8::gemm_phase<pg8::EpiResX, pg8::SchedSimple, false, true>(F.lds, 512, 512, S, E);
        }
        SEAM(P + 11);
        if (PHON(12) && IN(P + 12)) { PHASE_PROLOG(l) unsigned char* ws = WSP(); reduce_ss((const float*)(ws + WS_SS), (float*)(ws + WS_RS), GW * 64 + LN, NGW * 64); }
        SEAM(P + 12);
        if (PHON(13) && IN(P + 13)) { PHASE_PROLOG(l)
            unsigned char* ws = WSP();
            pg8::SchedSimple S; S.init(WSB(WS_X16), DM, WSB(WS_WL + WL_GU), DM, M, 2 * DFF, DM, GG, BX);
            pg8::EpiSwiglu E{WSB(WS_IN), (const float*)(ws + WS_RS)};
            pg8::gemm_phase<pg8::EpiSwiglu, pg8::SchedSimple, true, true, true>(F.lds, DM, DM, S, E);
        }
        SEAM(P + 13);
        if (PHON(14) && IN(P + 14)) { PHASE_PROLOG(l)
            unsigned char* ws = WSP();
            pg8::SchedSimple S; S.init(WSB(WS_IN), DFF, WSB(WS_WL + WL_DN), DFF, M, DM, DFF, GG, BX);
            if (LQ == DEPTH - 1) { pg8::EpiResF E{(const f16_t*)(ws + WS_X16), OUTP()}; pg8::gemm_phase<pg8::EpiResF, pg8::SchedSimple, false, true>(F.lds, DFF, DFF, S, E); }
            else { pg8::EpiResX E{(f16_t*)(ws + WS_X16), (float*)(ws + WS_SS)}; pg8::gemm_phase<pg8::EpiResX, pg8::SchedSimple, false, true>(F.lds, DFF, DFF, S, E); }
        }
        SEAM(P + 14);
    }
#undef IN
#undef SEAM
#undef WSB
}

extern "C" void kernel_launch(void* const* d_in, const int* in_sizes, int n_in, void* d_out, int out_size, void* d_ws, size_t ws_size, hipStream_t stream) {
    static int grid = 0;
    if (grid == 0) {
        if (n_in != 27 || out_size != M * DM || ws_size < WS_END) { fprintf(stderr, "kernel_launch: unexpected shapes: n_in %d out %d ws %zu (need %zu)\n", n_in, out_size, ws_size, (size_t)WS_END); grid = -1; return; }
        int dev = 0, cus = 0;
        if (hipGetDevice(&dev) != hipSuccess || hipDeviceGetAttribute(&cus, hipDeviceAttributeMultiprocessorCount, dev) != hipSuccess) { grid = -1; return; }
        if (hipFuncSetAttribute((const void*)trunk_fwd, hipFuncAttributeMaxDynamicSharedMemorySize, LDS_BYTES) != hipSuccess) { fprintf(stderr, "kernel_launch: hipFuncSetAttribute failed\n"); grid = -1; return; }
        int per_cu = 0;
        if (hipOccupancyMaxActiveBlocksPerMultiprocessor(&per_cu, (const void*)trunk_fwd, NWAVES * 64, LDS_BYTES) != hipSuccess || per_cu < 1) fprintf(stderr, "kernel_launch: occupancy query says %d\n", per_cu);
        (void)hipGetLastError();
        grid = cus;
    }
    if (grid < 0) return;
    (void)hipMemsetAsync((char*)d_ws + WS_CTL, 0, CTL_ZERO_BYTES, stream);
    Args a{};
    for (int i = 0; i < 27; ++i) a.in[i] = (const float*)d_in[i];
    a.pos = (const int*)d_in[2]; a.out = (float*)d_out; a.ws = (unsigned char*)d_ws;
#if MK_ONE_LAUNCH
    a.ph_lo = 0; a.ph_hi = NPHASE;
    hipLaunchKernelGGL(trunk_fwd, dim3(grid), dim3(NWAVES * 64), LDS_BYTES, stream, a);
#else
    for (int p = 0; p < NPHASE; ++p) { a.ph_lo = p; a.ph_hi = p + 1; hipLaunchKernelGGL(trunk_fwd, dim3(grid), dim3(NWAVES * 64), LDS_BYTES, stream, a); }
#endif
    if (PROBE_SET) {
        for (int l = 0; l < DEPTH; ++l) for (int k = 0; k < NP; ++k) if ((PROBE_SET >> k) & 1ull) {
            Args b = a; b.ph_lo = NPRE + l * NP + k; b.ph_hi = b.ph_lo + 1;
            if (k == 7) b.out = (float*)((unsigned char*)d_ws + WS_IN); if (k == 11 || k == 14 || k == 8 || k == 12) b.out = (float*)((unsigned char*)d_ws + WS_XN);
            hipLaunchKernelGGL(trunk_fwd, dim3(grid), dim3(NWAVES * 64), LDS_BYTES, stream, b); }
    }
    const hipError_t le = hipPeekAtLastError();
    if (le != hipSuccess) fprintf(stderr, "kernel_launch: launch failed: %s\n", hipGetErrorName(le));
}
```
